# Optimizing an MI355X kernel written in HIP

```python
import jax, jax.numpy as jnp
from jax import lax
import numpy as np

D_MODEL = 1024
BATCH = 8
SEQ = 2048
DEPTH = 2
DEC_BATCH = 128
DEC_SEQ = 1
PAST_LEN = 8192
PAGE_SIZE = 128

D_POOL = D_MODEL // 4
POOL_WINDOWS = (2, 4, 8, 16)
N_POOL_GROUPS = 4
POOL_GC = D_POOL // N_POOL_GROUPS
POOL_BUF = 15
D_SGU = D_MODEL // 4
CHUNK = 128
N_SGU_GROUPS = 4
SGU_GC = D_SGU // N_SGU_GROUPS
HEAD_DIM = 64
N_HEADS = (D_MODEL // 2) // HEAD_DIM
N_KV_HEADS = 2
Q_PER_KV = N_HEADS // N_KV_HEADS
D_ATTN = N_HEADS * HEAD_DIM
D_KV = N_KV_HEADS * HEAD_DIM
WINDOW = 128
BLOCK = 128
ROPE_THETA = 10000.0
N_BRANCHES = 3
SPLIT_SIZES = (D_POOL, D_POOL, D_SGU, D_SGU, D_SGU, D_ATTN, D_KV, D_KV, D_ATTN, N_BRANCHES * D_MODEL)
D_IN = 2 * D_POOL + 3 * D_SGU + 2 * D_ATTN + 2 * D_KV + N_BRANCHES * D_MODEL
V_OFF = 2 * D_POOL + 3 * D_SGU + D_ATTN + D_KV
ALPHA = (2.0 * DEPTH) ** 0.25
BETA = (8.0 * DEPTH) ** -0.25
LN_EPS = 1e-5
NEG_INF = -1e30

kernel_name = "hybrid_pool_sgu_swa_decoder_step"


def layer_norm(x, g, b):
    xf = x.astype(jnp.float32)
    mu = xf.mean(-1, keepdims=True)
    var = jnp.square(xf - mu).mean(-1, keepdims=True)
    y = (xf - mu) * lax.rsqrt(var + LN_EPS)
    return (y * g.astype(jnp.float32) + b.astype(jnp.float32)).astype(x.dtype)


def split_in(h):
    offs = np.cumsum(SPLIT_SIZES)[:-1].tolist()
    return jnp.split(h, offs, axis=-1)


def rope(x, pos):
    half = HEAD_DIM // 2
    inv = ROPE_THETA ** (-jnp.arange(half, dtype=jnp.float32) / half)
    ang = pos.astype(jnp.float32)[:, None] * inv[None, :]
    cos = jnp.cos(ang)[None, :, None, :]
    sin = jnp.sin(ang)[None, :, None, :]
    xf = x.astype(jnp.float32)
    x1, x2 = xf[..., :half], xf[..., half:]
    return jnp.concatenate([x1 * cos - x2 * sin, x2 * cos + x1 * sin], axis=-1).astype(x.dtype)


def pool_mix(xa_ext, n_hist, pos, pool_w, pool_scale):
    B, L, _ = xa_ext.shape
    T = L - n_hist
    xg = xa_ext.astype(jnp.float32).reshape(B, L, N_POOL_GROUPS, POOL_GC)
    cs = jnp.cumsum(xg, axis=1)
    outs = []
    for g, w in enumerate(POOL_WINDOWS):
        csg = cs[:, :, g]
        shifted = jnp.pad(csg, ((0, 0), (w, 0), (0, 0)))[:, :L]
        win_sum = (csg - shifted)[:, n_hist:]
        cnt = jnp.minimum(pos + 1, w).astype(jnp.float32)
        outs.append(win_sum / cnt[None, :, None] - xg[:, n_hist:, g])
    pooled = jnp.stack(outs, axis=2)
    mixed = jnp.einsum('btgc,gcd->btgd', pooled, pool_w.astype(jnp.float32)).reshape(B, T, D_POOL)
    return (mixed * pool_scale.astype(jnp.float32)).astype(xa_ext.dtype)


def sgu_spatial(v_chunks, sgu_w, sgu_b):
    tc = v_chunks.shape[2]
    mask = jnp.tril(jnp.ones((tc, tc), dtype=bool))
    w = jnp.where(mask[None], sgu_w[:, :tc, :tc], 0.0).astype(v_chunks.dtype)
    s = jnp.einsum('gts,bnsgc->bntgc', w, v_chunks)
    return s + jnp.transpose(sgu_b[:, :tc])[None, None, :, :, None].astype(v_chunks.dtype)


def sink_softmax(scores, allowed, sinks):
    scores = jnp.where(allowed, scores, NEG_INF)
    sink = sinks.astype(jnp.float32).reshape(N_KV_HEADS, Q_PER_KV, 1, 1)
    m = jnp.maximum(scores.max(-1, keepdims=True), sink)
    p = jnp.exp(scores - m)
    return p / (p.sum(-1, keepdims=True) + jnp.exp(sink - m))


def banded_window_attention(q, k, v, sinks):
    B, L = q.shape[:2]
    NB = L // BLOCK
    qb = q.reshape(B, NB, BLOCK, N_KV_HEADS, Q_PER_KV, HEAD_DIM)
    kb = k.reshape(B, NB, BLOCK, N_KV_HEADS, HEAD_DIM)
    vb = v.reshape(B, NB, BLOCK, N_KV_HEADS, HEAD_DIM)
    pad = ((0, 0), (1, 0), (0, 0), (0, 0), (0, 0))
    keys = jnp.concatenate([jnp.pad(kb, pad)[:, :NB], kb], axis=2)
    vals = jnp.concatenate([jnp.pad(vb, pad)[:, :NB], vb], axis=2)
    scores = jnp.einsum('bnqkgd,bnskd->bnkgqs', qb, keys).astype(jnp.float32) * (HEAD_DIM ** -0.5)
    blk = jnp.arange(NB, dtype=jnp.int32)[:, None] * BLOCK
    q_pos = blk + jnp.arange(BLOCK, dtype=jnp.int32)[None, :]
    k_pos = blk - BLOCK + jnp.arange(2 * BLOCK, dtype=jnp.int32)[None, :]
    diff = q_pos[:, :, None] - k_pos[:, None, :]
    allowed = (diff >= 0) & (diff <= WINDOW) & (k_pos[:, None, :] >= 0)
    probs = sink_softmax(scores, allowed[None, :, None, None], sinks)
    out = jnp.einsum('bnkgqs,bnskd->bnqkgd', probs.astype(vals.dtype), vals)
    return out.reshape(B, L, D_ATTN)


def window_decode_attention(q, keys, vals, pos, sinks):
    Bd, T = q.shape[:2]
    qg = q.reshape(Bd, T, N_KV_HEADS, Q_PER_KV, HEAD_DIM)
    scores = jnp.einsum('btkgd,bskd->bkgts', qg, keys).astype(jnp.float32) * (HEAD_DIM ** -0.5)
    k_pos = jnp.concatenate([PAST_LEN - WINDOW + jnp.arange(WINDOW, dtype=jnp.int32), pos])
    diff = pos[:, None] - k_pos[None, :]
    allowed = (diff >= 0) & (diff <= WINDOW)
    probs = sink_softmax(scores, allowed, sinks)
    out = jnp.einsum('bkgts,bskd->btkgd', probs.astype(vals.dtype), vals)
    return out.reshape(Bd, T, D_ATTN)


def merge_and_norm(x, ya, za, yb, zb, yc, zc, gates, b_gate, w_pa, w_pb, w_pc, w_out, ln_g, ln_b):
    lead = gates.shape[:-1]
    g = jax.nn.sigmoid((gates.reshape(lead + (N_BRANCHES, D_MODEL)) + b_gate).astype(jnp.float32)).astype(x.dtype)
    oa = jnp.einsum('blc,cd->bld', ya * jax.nn.silu(za), w_pa)
    ob = jnp.einsum('blc,cd->bld', yb * jax.nn.silu(zb), w_pb)
    oc = jnp.einsum('blc,cd->bld', yc * jax.nn.silu(zc), w_pc)
    merged = g[..., 0, :] * oa + g[..., 1, :] * ob + g[..., 2, :] * oc
    out = jnp.einsum('bld,de->ble', merged, w_out)
    return layer_norm(ALPHA * x + out, ln_g, ln_b)


def layer_prompt(x, w_in, b_gate, pool_w, pool_scale, sgu_ln_g, sgu_ln_b, sgu_w, sgu_b, attn_sinks,
                 w_pa, w_pb, w_pc, w_out, ln_g, ln_b):
    B, L, _ = x.shape
    pos = jnp.arange(L, dtype=jnp.int32)
    xa, za, u, v, zb, q, k, vv, zc, gates = split_in(jnp.einsum('bld,de->ble', x, w_in))
    ya = pool_mix(xa, 0, pos, pool_w, pool_scale)
    vn = layer_norm(v, sgu_ln_g, sgu_ln_b)
    yb = u * sgu_spatial(vn.reshape(B, L // CHUNK, CHUNK, N_SGU_GROUPS, SGU_GC), sgu_w, sgu_b).reshape(B, L, D_SGU)
    qr = rope(q.reshape(B, L, N_HEADS, HEAD_DIM), pos)
    kr = rope(k.reshape(B, L, N_KV_HEADS, HEAD_DIM), pos)
    vr = vv.reshape(B, L, N_KV_HEADS, HEAD_DIM)
    yc = banded_window_attention(qr, kr, vr, attn_sinks)
    y = merge_and_norm(x, ya, za, yb, zb, yc, zc, gates, b_gate, w_pa, w_pb, w_pc, w_out, ln_g, ln_b)
    return y, xa[:, L - POOL_BUF:], kr[:, L - WINDOW:], vr[:, L - WINDOW:]


def layer_sample(x, pool_buf, k_buf, v_buf, w_in, b_gate, pool_w, pool_scale, sgu_ln_g, sgu_ln_b, sgu_w, sgu_b,
                 attn_sinks, w_pa, w_pb, w_pc, w_out, ln_g, ln_b):
    Bd, T, _ = x.shape
    pos = PAST_LEN + jnp.arange(T, dtype=jnp.int32)
    xa, za, u, v, zb, q, k, vv, zc, gates = split_in(jnp.einsum('bld,de->ble', x, w_in))
    xa_ext = jnp.concatenate([pool_buf.astype(xa.dtype), xa], axis=1)
    ya = pool_mix(xa_ext, POOL_BUF, pos, pool_w, pool_scale)
    vn = layer_norm(v, sgu_ln_g, sgu_ln_b)
    yb = u * sgu_spatial(vn.reshape(Bd, 1, T, N_SGU_GROUPS, SGU_GC), sgu_w, sgu_b).reshape(Bd, T, D_SGU)
    qr = rope(q.reshape(Bd, T, N_HEADS, HEAD_DIM), pos)
    kr = rope(k.reshape(Bd, T, N_KV_HEADS, HEAD_DIM), pos)
    vr = vv.reshape(Bd, T, N_KV_HEADS, HEAD_DIM)
    keys = jnp.concatenate([k_buf.astype(kr.dtype), kr], axis=1)
    vals = jnp.concatenate([v_buf.astype(vr.dtype), vr], axis=1)
    yc = window_decode_attention(qr, keys, vals, pos, attn_sinks)
    y = merge_and_norm(x, ya, za, yb, zb, yc, zc, gates, b_gate, w_pa, w_pb, w_pc, w_out, ln_g, ln_b)
    return y, xa_ext[:, T:], keys[:, T:], vals[:, T:], vn


def setup_inputs(seed: int = 0) -> dict:
    key = jax.random.key(seed)
    ks = jax.random.split(key, 20)
    f32 = jnp.float32
    nrm = lambda k, s: jax.random.normal(k, s, dtype=f32)
    w_in = nrm(ks[5], (DEPTH, D_MODEL, D_IN)) * D_MODEL ** -0.5
    w_in = w_in.at[:, :, V_OFF:V_OFF + D_KV].multiply(BETA)
    return {
        "x_prompt": nrm(ks[0], (BATCH, SEQ, D_MODEL)),
        "x_sample": nrm(ks[1], (DEC_BATCH, DEC_SEQ, D_MODEL)),
        "state_pool": nrm(ks[2], (DEPTH, DEC_BATCH, POOL_BUF, D_POOL)),
        "cache_k_win": nrm(ks[3], (DEPTH, DEC_BATCH, WINDOW, N_KV_HEADS, HEAD_DIM)),
        "cache_v_win": nrm(ks[4], (DEPTH, DEC_BATCH, WINDOW, N_KV_HEADS, HEAD_DIM)),
        "w_in": w_in,
        "b_gate": 0.02 * nrm(ks[6], (DEPTH, N_BRANCHES, D_MODEL)),
        "pool_w": nrm(ks[7], (DEPTH, N_POOL_GROUPS, POOL_GC, POOL_GC)) * POOL_GC ** -0.5,
        "pool_scale": 1.0 + 0.1 * nrm(ks[8], (DEPTH, D_POOL)),
        "sgu_ln_g": 1.0 + 0.1 * nrm(ks[9], (DEPTH, D_SGU)),
        "sgu_ln_b": 0.02 * nrm(ks[10], (DEPTH, D_SGU)),
        "sgu_w": nrm(ks[11], (DEPTH, N_SGU_GROUPS, CHUNK, CHUNK)) * CHUNK ** -0.5,
        "sgu_b": 1.0 + 0.1 * nrm(ks[12], (DEPTH, N_SGU_GROUPS, CHUNK)),
        "attn_sinks": 0.5 * nrm(ks[13], (DEPTH, N_HEADS)),
        "w_proj_a": nrm(ks[14], (DEPTH, D_POOL, D_MODEL)) * D_POOL ** -0.5 * BETA,
        "w_proj_b": nrm(ks[15], (DEPTH, D_SGU, D_MODEL)) * D_SGU ** -0.5 * BETA,
        "w_proj_c": nrm(ks[16], (DEPTH, D_ATTN, D_MODEL)) * D_ATTN ** -0.5 * BETA,
        "w_out": nrm(ks[17], (DEPTH, D_MODEL, D_MODEL)) * D_MODEL ** -0.5 * BETA,
        "ln_g": 1.0 + 0.1 * nrm(ks[18], (DEPTH, D_MODEL)),
        "ln_b": 0.02 * nrm(ks[19], (DEPTH, D_MODEL)),
    }


def reference(x_prompt, x_sample, state_pool, cache_k_win, cache_v_win, w_in, b_gate, pool_w, pool_scale,
              sgu_ln_g, sgu_ln_b, sgu_w, sgu_b, attn_sinks, w_proj_a, w_proj_b, w_proj_c, w_out, ln_g, ln_b):
    y_p, y_s = x_prompt, x_sample
    pool_p, kp, vp, pool_s, ksm, vsm, chunk_v = [], [], [], [], [], [], []
    for l in range(DEPTH):
        lw = (w_in[l], b_gate[l], pool_w[l], pool_scale[l], sgu_ln_g[l], sgu_ln_b[l], sgu_w[l], sgu_b[l],
              attn_sinks[l], w_proj_a[l], w_proj_b[l], w_proj_c[l], w_out[l], ln_g[l], ln_b[l])
        y_p, sp, kpl, vpl = layer_prompt(y_p, *lw)
        y_s, ss, ksl, vsl, cvl = layer_sample(y_s, state_pool[l], cache_k_win[l], cache_v_win[l], *lw)
        pool_p.append(sp); kp.append(kpl); vp.append(vpl)
        pool_s.append(ss); ksm.append(ksl); vsm.append(vsl); chunk_v.append(cvl)
    new_state_pool_prompt = jnp.stack(pool_p)
    new_cache_k_win_prompt = jnp.stack(kp)
    new_cache_v_win_prompt = jnp.stack(vp)
    new_state_pool_sample = jnp.stack(pool_s)
    new_cache_k_win_sample = jnp.stack(ksm)
    new_cache_v_win_sample = jnp.stack(vsm)
    new_state_chunk_v_sample = jnp.stack(chunk_v)
    return (y_p, y_s, new_state_pool_prompt, new_cache_k_win_prompt, new_cache_v_win_prompt,
            new_state_pool_sample, new_cache_k_win_sample, new_cache_v_win_sample, new_state_chunk_v_sample)
```

```cpp
#include <hip/hip_runtime.h>
#include <hip/hip_cooperative_groups.h>
#include <cstdio>
#include <cstdint>
namespace cg = cooperative_groups;

#define LAS __attribute__((address_space(3)))
#define GAS __attribute__((address_space(1)))
typedef unsigned short bf16_t;
typedef short bf16x8 __attribute__((ext_vector_type(8)));
typedef float f32x4 __attribute__((ext_vector_type(4)));
typedef float f32x2 __attribute__((ext_vector_type(2)));
typedef float f32x16 __attribute__((ext_vector_type(16)));
typedef unsigned u32x4 __attribute__((ext_vector_type(4)));
typedef unsigned u32x2 __attribute__((ext_vector_type(2)));

constexpr int DM = 1024, NB = 8, SEQ = 2048, DEPTH = 2, DB = 128;
constexpr int MP = NB * SEQ;
constexpr int MS = DB;
constexpr int MREAL = MP + MS;
constexpr int MPAD = 16640;
constexpr int DIN = 5632, H1W = 2560, GW = 3072;
constexpr int C_XA = 0, C_ZA = 256, C_U = 512, C_V = 768, C_ZB = 1024, C_Q = 1280, C_K = 1792, C_VV = 1920, C_ZC = 2048;
constexpr float ALPHA = 1.4142135623730951f;
constexpr float LN_EPS = 1e-5f;
constexpr float LOG2E = 1.4426950408889634f;
constexpr size_t O_YP = 0, O_YS = 16777216, O_POOLP = 16908288, O_KP = 16969728, O_VP = 17231872, O_POOLS = 17494016,
                 O_KS = 18477056, O_VS = 22671360, O_CVS = 26865664;
constexpr size_t MiB = 1u << 20;
constexpr size_t WS_CTL = 0, CTL_ZERO_BYTES = 65536;
constexpr size_t WS_ROPE = 1 * MiB;
constexpr size_t WS_PWT = 2 * MiB;
constexpr size_t WS_WIN = 4 * MiB;
constexpr size_t WS_WP = 26 * MiB;
constexpr size_t WS_WOUT = 30 * MiB;
constexpr size_t WS_X1 = 34 * MiB;
constexpr size_t WS_H1 = 67 * MiB;
constexpr size_t WS_GT = 149 * MiB;
constexpr size_t WS_END = 247 * MiB;
constexpr int ROPE_N = 2049 * 32;

typedef __bf16 bf16x2_t __attribute__((ext_vector_type(2)));
__device__ __forceinline__ unsigned cvt_pk_bf16(float lo, float hi) { f32x2 v = {lo, hi}; bf16x2_t b = __builtin_convertvector(v, bf16x2_t); return __builtin_bit_cast(unsigned, b); }
__device__ __forceinline__ float bf_lo(unsigned w) { return __uint_as_float(w << 16); }
__device__ __forceinline__ float bf_hi(unsigned w) { return __uint_as_float(w & 0xffff0000u); }
__device__ __forceinline__ float bf2f(bf16_t b) { return __uint_as_float((unsigned)b << 16); }
__device__ __forceinline__ float sigmoidf_(float v) { return __builtin_amdgcn_rcpf(1.0f + __builtin_amdgcn_exp2f(-v * LOG2E)); }
__device__ __forceinline__ float siluf_(float v) { return v * sigmoidf_(v); }
__device__ __forceinline__ int opaque_tid() { int t = threadIdx.x; asm volatile("" : "+v"(t)); return t; }
__device__ __forceinline__ float wave_sum(float v) {
#pragma unroll
    for (int o = 1; o < 64; o <<= 1) v += __shfl_xor(v, o);
    return v;
}
__device__ __forceinline__ float wave_max(float v) {
#pragma unroll
    for (int o = 1; o < 64; o <<= 1) v = fmaxf(v, __shfl_xor(v, o));
    return v;
}

namespace pg8 {
#define PG8_LAS __attribute__((address_space(3)))
constexpr int BM = 256, BK = 64, HALF = 128, HTB = HALF * BK * 2, STAGE_BYTES = 8 * HTB, NXCD = 8, WGM = 8;
__host__ __device__ __forceinline__ int lds_byte(int r, int c) { const int st = (r >> 4) * 2 + (c >> 5), rr = r & 15, cc = c & 31, ob = rr * 64 + cc * 2; return st * 1024 + (ob ^ (((ob >> 9) & 1) << 5)); }
__host__ __device__ __forceinline__ void stage_rc(int b, int& R, int& C) { const int st = b / 1024, sb = b % 1024, swz = sb ^ (((sb >> 9) & 1) << 5); R = (st >> 1) * 16 + swz / 64; C = (st & 1) * 32 + (swz % 64) / 2; }
__host__ __device__ __forceinline__ int perm32(int rho) { const int n = rho >> 4, i = rho & 15; return 8 * (i >> 2) + 4 * n + (i & 3); }

struct Unit { int pm, pn; };
struct Gemm { const bf16_t* A; const bf16_t* Bt; int M, N, K; };

struct StaticOrder {
    int nM, nN, nwg, G, c;
    __host__ __device__ void init(int M, int N, int G_, int c_) { nM = M / BM; nN = N / BM; nwg = nM * nN; G = G_; c = c_; }
    __host__ __device__ bool next(int i, Unit& u) const {
        const long L = (long)i * G + c; if (L >= nwg) return false;
        int wgid = (int)L; { const int q = nwg / NXCD, r = nwg % NXCD, xcd = wgid % NXCD, off = wgid / NXCD; wgid = (xcd < r ? xcd * (q + 1) : r * (q + 1) + (xcd - r) * q) + off; }
        const int nig = WGM * nN, gid = wgid / nig, fm = gid * WGM, gsz = (nM - fm) < WGM ? (nM - fm) : WGM;
        u.pm = fm + ((wgid % nig) % gsz); u.pn = (wgid % nig) / gsz; return true;
    }
    __device__ __forceinline__ void a_ready(const Unit&) const {}
    __device__ __forceinline__ void done(const Unit&) const {}
};


struct EpiInProj {
    static constexpr bool PERM = true, AFTER_DRAIN = false, HAS_MID = false;
    bf16_t* H1; bf16_t* GT; const float* bgate; const float* ropec; const float* ropes;
    __device__ __forceinline__ void mid(f32x4 (&)[2][2][4][2], const Unit&, int, int, int, int, int) const {}
    __device__ __forceinline__ void operator()(const f32x4 (&acc)[2][2][4][2], const Unit& u, int wr, int wc, int fr, int fq) const {
        int row0 = u.pm * BM + wr * 64 + fr;
        asm volatile("" : "+v"(row0));
        if (u.pn >= 10) {
            const int colg = (u.pn - 10) * BM + wc * 32 + 8 * fq;
            f32x4 bv[2][2];
#pragma unroll
            for (int bj = 0; bj < 2; ++bj)
#pragma unroll
                for (int n = 0; n < 2; ++n) bv[bj][n] = *(const f32x4*)(bgate + colg + bj * HALF + 4 * n);
#pragma unroll
            for (int ai = 0; ai < 2; ++ai)
#pragma unroll
                for (int m = 0; m < 4; ++m) { bf16_t* rowp = GT + (size_t)(row0 + ai * HALF + m * 16) * GW + colg;
#pragma unroll
                    for (int bj = 0; bj < 2; ++bj) { const f32x4 v0 = acc[ai][bj][m][0] + bv[bj][0], v1 = acc[ai][bj][m][1] + bv[bj][1];
                        u32x4 w; w.x = cvt_pk_bf16(sigmoidf_(v0[0]), sigmoidf_(v0[1])); w.y = cvt_pk_bf16(sigmoidf_(v0[2]), sigmoidf_(v0[3]));
                        w.z = cvt_pk_bf16(sigmoidf_(v1[0]), sigmoidf_(v1[1])); w.w = cvt_pk_bf16(sigmoidf_(v1[2]), sigmoidf_(v1[3]));
                        *(u32x4*)(rowp + bj * HALF) = w; } }
        } else {
            const int colt = u.pn * BM;
            const bool anyrope = (u.pn >= 5 && u.pn <= 7);
            const int d0 = 16 * (wc & 1) + 4 * fq;
#pragma unroll
            for (int ai = 0; ai < 2; ++ai)
#pragma unroll
                for (int m = 0; m < 4; ++m) { const int row = row0 + ai * HALF + m * 16; bf16_t* rowp = H1 + (size_t)row * H1W + colt;
                    f32x4 c4 = (f32x4){1.f, 1.f, 1.f, 1.f}, s4 = (f32x4){0.f, 0.f, 0.f, 0.f};
                    if (anyrope) { const int pidx = row < MP ? (row & (SEQ - 1)) : 2048; c4 = *(const f32x4*)(ropec + pidx * 32 + d0); s4 = *(const f32x4*)(ropes + pidx * 32 + d0); }
#pragma unroll
                    for (int bj = 0; bj < 2; ++bj) {
                        const bool rp = (u.pn == 5 || u.pn == 6 || (u.pn == 7 && bj == 0));
                        const f32x4 x1 = acc[ai][bj][m][0], x2 = acc[ai][bj][m][1];
                        if (rp) {
                            const f32x4 y1 = x1 * c4 - x2 * s4, y2 = x2 * c4 + x1 * s4;
                            bf16_t* hp = rowp + bj * HALF + 64 * (wc >> 1) + d0;
                            u32x2 a; a.x = cvt_pk_bf16(y1[0], y1[1]); a.y = cvt_pk_bf16(y1[2], y1[3]);
                            u32x2 b; b.x = cvt_pk_bf16(y2[0], y2[1]); b.y = cvt_pk_bf16(y2[2], y2[3]);
                            *(u32x2*)hp = a; *(u32x2*)(hp + 32) = b;
                        } else {
                            u32x4 w; w.x = cvt_pk_bf16(x1[0], x1[1]); w.y = cvt_pk_bf16(x1[2], x1[3]); w.z = cvt_pk_bf16(x2[0], x2[1]); w.w = cvt_pk_bf16(x2[2], x2[3]);
                            *(u32x4*)(rowp + bj * HALF + wc * 32 + 8 * fq) = w;
                        }
                    }
                    asm volatile("" ::: "memory"); }
        }
    }
};

struct EpiMerge {
    static constexpr bool PERM = true, AFTER_DRAIN = false, HAS_MID = true;
    bf16_t* O; const bf16_t* GT;
    __device__ __forceinline__ void mid(f32x4 (&acc)[2][2][4][2], const Unit& u, int wr, int wc, int fr, int fq, int which) const {
        int row0 = u.pm * BM + wr * 64 + fr, col0 = u.pn * BM + wc * 32 + 8 * fq;
        asm volatile("" : "+v"(row0), "+v"(col0));
#pragma unroll
        for (int ai = 0; ai < 2; ++ai)
#pragma unroll
            for (int m = 0; m < 4; ++m) { const bf16_t* gp = GT + (size_t)(row0 + ai * HALF + m * 16) * GW + which * DM + col0;
#pragma unroll
                for (int bj = 0; bj < 2; ++bj) { const u32x4 ga = *(const u32x4*)(gp + bj * HALF), gb = *(const u32x4*)(gp + DM + bj * HALF);
                    f32x4 r0, r1;
                    r0[0] = bf_lo(ga.x) * __builtin_amdgcn_rcpf(fmaxf(bf_lo(gb.x), 1e-30f)); r0[1] = bf_hi(ga.x) * __builtin_amdgcn_rcpf(fmaxf(bf_hi(gb.x), 1e-30f));
                    r0[2] = bf_lo(ga.y) * __builtin_amdgcn_rcpf(fmaxf(bf_lo(gb.y), 1e-30f)); r0[3] = bf_hi(ga.y) * __builtin_amdgcn_rcpf(fmaxf(bf_hi(gb.y), 1e-30f));
                    r1[0] = bf_lo(ga.z) * __builtin_amdgcn_rcpf(fmaxf(bf_lo(gb.z), 1e-30f)); r1[1] = bf_hi(ga.z) * __builtin_amdgcn_rcpf(fmaxf(bf_hi(gb.z), 1e-30f));
                    r1[2] = bf_lo(ga.w) * __builtin_amdgcn_rcpf(fmaxf(bf_lo(gb.w), 1e-30f)); r1[3] = bf_hi(ga.w) * __builtin_amdgcn_rcpf(fmaxf(bf_hi(gb.w), 1e-30f));
                    acc[ai][bj][m][0] *= r0; acc[ai][bj][m][1] *= r1; }
                asm volatile("" ::: "memory"); }
    }
    __device__ __forceinline__ void operator()(const f32x4 (&acc)[2][2][4][2], const Unit& u, int wr, int wc, int fr, int fq) const {
        int row0 = u.pm * BM + wr * 64 + fr, col0 = u.pn * BM + wc * 32 + 8 * fq;
        asm volatile("" : "+v"(row0), "+v"(col0));
#pragma unroll
        for (int ai = 0; ai < 2; ++ai)
#pragma unroll
            for (int m = 0; m < 4; ++m) { const size_t row = (size_t)(row0 + ai * HALF + m * 16); const bf16_t* gp = GT + row * GW + 2 * DM + col0; bf16_t* op = O + row * DM + col0;
#pragma unroll
                for (int bj = 0; bj < 2; ++bj) { const u32x4 g = *(const u32x4*)(gp + bj * HALF); const f32x4 v0 = acc[ai][bj][m][0], v1 = acc[ai][bj][m][1];
                    u32x4 w; w.x = cvt_pk_bf16(v0[0] * bf_lo(g.x), v0[1] * bf_hi(g.x)); w.y = cvt_pk_bf16(v0[2] * bf_lo(g.y), v0[3] * bf_hi(g.y));
                    w.z = cvt_pk_bf16(v1[0] * bf_lo(g.z), v1[1] * bf_hi(g.z)); w.w = cvt_pk_bf16(v1[2] * bf_lo(g.w), v1[3] * bf_hi(g.w));
                    *(u32x4*)(op + bj * HALF) = w; }
                asm volatile("" ::: "memory"); }
    }
};

struct EpiOut {
    static constexpr bool PERM = false, AFTER_DRAIN = false, HAS_MID = false;
    float* T; const float* xp; const float* xs; const bf16_t* X1; int layer;
    __device__ __forceinline__ void mid(f32x4 (&)[2][2][4][2], const Unit&, int, int, int, int, int) const {}
    __device__ __forceinline__ void operator()(const f32x4 (&acc)[2][2][4][2], const Unit& u, int wr, int wc, int fr, int fq) const {
        int row0 = u.pm * BM + wr * 64 + fr, col0 = u.pn * BM + wc * 32 + 4 * fq;
        asm volatile("" : "+v"(row0), "+v"(col0));
#pragma unroll
        for (int ai = 0; ai < 2; ++ai)
#pragma unroll
            for (int m = 0; m < 4; ++m) { const int row = row0 + ai * HALF + m * 16; float* tp = T + (size_t)row * DM + col0;
#pragma unroll
                for (int bj = 0; bj < 2; ++bj)
#pragma unroll
                    for (int n = 0; n < 2; ++n) { const int co = bj * HALF + n * 16; f32x4 x = (f32x4){0.f, 0.f, 0.f, 0.f};
                        if (layer == 0) { if (row < MP) x = *(const f32x4*)(xp + (size_t)row * DM + col0 + co); else if (row < MREAL) x = *(const f32x4*)(xs + (size_t)(row - MP) * DM + col0 + co); }
                        else { const u32x2 w = *(const u32x2*)(X1 + (size_t)row * DM + col0 + co); x = (f32x4){bf_lo(w.x), bf_hi(w.x), bf_lo(w.y), bf_hi(w.y)}; }
                        *(f32x4*)(tp + co) = x * ALPHA + acc[ai][bj][m][n]; } }
    }
};

template <class Epi, class Sched, bool ALIGN_EPI = false, bool SP2 = false>
__device__ __forceinline__ void gemm_phase(PG8_LAS unsigned char* lds, const Gemm g, const Sched& S, const Epi& E) {
    const int tid = opaque_tid(), wid = __builtin_amdgcn_readfirstlane(tid >> 6), lane = tid & 63, wr = wid >> 2, wc = wid & 3, fr = lane & 15, fq = lane >> 4;
    const int K = g.K, nt = K / BK;
    unsigned voffA, voffB;
    { int R, C; stage_rc(tid * 16, R, C); const int Rb = Epi::PERM ? ((R & ~31) + perm32(R & 31)) : R;
        voffA = (unsigned)(R * K + C) * 2u; voffB = (unsigned)(Rb * K + C) * 2u; }
    const size_t pstep = (size_t)64 * K * 2;
    const size_t kstep = (size_t)(BK * 2);
    const size_t hstep = (size_t)HALF * K * 2;
    const size_t tstep = 2 * hstep;
    const unsigned ldsw = (unsigned)wid * 1024u;
    const int aoff = lds_byte(wr * 64 + fr, fq * 8); int boffB = lds_byte(wc * 32 + fr, fq * 8) + 4 * HTB;
    asm volatile("" : "+v"(boffB));
#define PG8_SA(b, h) (((b) * 2 + (h)) * HTB)
#define PG8_SB(b, h) ((4 + (b) * 2 + (h)) * HTB)
#define PG8_SBR(b, h) (((b) * 2 + (h)) * HTB)
#define PG8_STAGE(bufoff, gbase, voff) do { _Pragma("unroll") for (int _i = 0; _i < 2; ++_i) \
        __builtin_amdgcn_global_load_lds((const unsigned*)((const char*)(gbase) + _i * pstep + (voff)), (PG8_LAS unsigned*)(lds + (bufoff) + ldsw + _i * 8192), 16, 0, 0); } while (0)
#define PG8_LDA(dst, b, h) do { _Pragma("unroll") for (int m = 0; m < 4; ++m) _Pragma("unroll") for (int k = 0; k < 2; ++k) dst[m][k] = *(const PG8_LAS bf16x8*)(lds + PG8_SA(b, h) + aoff + m * 2048 + k * 1024); } while (0)
#define PG8_LDB(dst, b, h) do { _Pragma("unroll") for (int n = 0; n < 2; ++n) _Pragma("unroll") for (int k = 0; k < 2; ++k) dst[n][k] = *(const PG8_LAS bf16x8*)(lds + boffB + (PG8_SBR(b, h) + n * 2048 + k * 1024)); } while (0)
#define PG8_MMA(ai, bj, At, Bt) do { __builtin_amdgcn_s_setprio(1); _Pragma("unroll") for (int m = 0; m < 4; ++m) _Pragma("unroll") for (int n = 0; n < 2; ++n) _Pragma("unroll") for (int k = 0; k < 2; ++k) \
        acc[ai][bj][m][n] = __builtin_amdgcn_mfma_f32_16x16x32_bf16(Bt[n][k], At[m][k], acc[ai][bj][m][n], 0, 0, 0); __builtin_amdgcn_s_setprio(0); } while (0)
#define PG8_WAIT_V(n) asm volatile("s_waitcnt vmcnt(" #n ")" ::: "memory")
#define PG8_WAIT_L(n) asm volatile("s_waitcnt lgkmcnt(" #n ")" ::: "memory")
#define PG8_BAR __builtin_amdgcn_s_barrier()
#define PG8_SCHED __builtin_amdgcn_sched_barrier(0)
#define PG8_KBODY() do { \
            const bool last = (t == nt - 2); \
            const char* a1 = cA + (size_t)(t + 1) * kstep; \
            const char* a2 = last ? nA : cA + (size_t)(t + 2) * kstep; const char* b2 = last ? nB : cB + (size_t)(t + 2) * kstep; \
            const char* a3 = a2 + kstep; const char* b3 = b2 + kstep; \
            if (last && has_next) S.a_ready(nxt); \
            if constexpr (SP2) { \
            PG8_LDB(B0, 0, 0); PG8_LDB(B1, 0, 1); PG8_SCHED; PG8_LDA(At, 0, 0); PG8_STAGE(PG8_SA(1, 1), a1 + hstep, voffA); \
            PG8_WAIT_V(8); PG8_WAIT_L(0); PG8_BAR; PG8_MMA(0, 0, At, B0); PG8_MMA(0, 1, At, B1); PG8_BAR; PG8_SCHED; \
            PG8_LDA(At, 0, 1); PG8_STAGE(PG8_SB(0, 0), b2, voffB); PG8_STAGE(PG8_SB(0, 1), b2 + hstep, voffB); PG8_STAGE(PG8_SA(0, 0), a2, voffA); \
            PG8_WAIT_V(8); PG8_WAIT_L(0); PG8_BAR; PG8_MMA(1, 0, At, B0); PG8_MMA(1, 1, At, B1); PG8_BAR; PG8_SCHED; \
            PG8_LDB(B0, 1, 0); PG8_LDB(B1, 1, 1); PG8_SCHED; PG8_LDA(At, 1, 0); PG8_STAGE(PG8_SA(0, 1), a2 + hstep, voffA); \
            PG8_WAIT_V(8); PG8_WAIT_L(0); PG8_BAR; PG8_MMA(0, 0, At, B0); PG8_MMA(0, 1, At, B1); PG8_BAR; PG8_SCHED; \
            PG8_LDA(At, 1, 1); PG8_STAGE(PG8_SB(1, 0), b3, voffB); PG8_STAGE(PG8_SB(1, 1), b3 + hstep, voffB); PG8_STAGE(PG8_SA(1, 0), a3, voffA); \
            PG8_WAIT_V(8); PG8_WAIT_L(0); PG8_BAR; PG8_MMA(1, 0, At, B0); PG8_MMA(1, 1, At, B1); PG8_BAR; PG8_SCHED; \
            } else { \
            PG8_LDB(B0, 0, 0); PG8_SCHED; PG8_LDA(At, 0, 0); PG8_STAGE(PG8_SA(1, 1), a1 + hstep, voffA); \
            PG8_WAIT_L(8); PG8_BAR; PG8_WAIT_L(0); PG8_MMA(0, 0, At, B0); PG8_BAR; PG8_SCHED; \
            PG8_LDB(B1, 0, 1); PG8_STAGE(PG8_SB(0, 0), b2, voffB); \
            PG8_BAR; PG8_WAIT_L(0); PG8_MMA(0, 1, At, B1); PG8_BAR; \
            PG8_LDA(At, 0, 1); PG8_STAGE(PG8_SA(0, 0), a2, voffA); \
            PG8_BAR; PG8_WAIT_L(0); PG8_MMA(1, 0, At, B0); PG8_BAR; PG8_SCHED; \
            PG8_STAGE(PG8_SB(0, 1), b2 + hstep, voffB); \
            PG8_WAIT_V(6); PG8_BAR; PG8_MMA(1, 1, At, B1); PG8_BAR; \
            PG8_LDB(B0, 1, 0); PG8_SCHED; PG8_LDA(At, 1, 0); PG8_STAGE(PG8_SA(0, 1), a2 + hstep, voffA); \
            PG8_WAIT_L(8); PG8_BAR; PG8_WAIT_L(0); PG8_MMA(0, 0, At, B0); PG8_BAR; PG8_SCHED; \
            PG8_LDB(B1, 1, 1); PG8_STAGE(PG8_SB(1, 0), b3, voffB); \
            PG8_BAR; PG8_WAIT_L(0); PG8_MMA(0, 1, At, B1); PG8_BAR; \
            PG8_LDA(At, 1, 1); PG8_STAGE(PG8_SA(1, 0), a3, voffA); \
            PG8_BAR; PG8_WAIT_L(0); PG8_MMA(1, 0, At, B0); PG8_BAR; PG8_SCHED; \
            PG8_STAGE(PG8_SB(1, 1), b3 + hstep, voffB); \
            PG8_WAIT_V(6); PG8_BAR; PG8_MMA(1, 1, At, B1); PG8_BAR; \
            } \
        } while (0)
    Unit cur, nxt; int ui = 0;
    if (!S.next(0, cur)) return;
    f32x4 acc[2][2][4][2];
#pragma unroll
    for (int a = 0; a < 2; ++a)
#pragma unroll
        for (int b = 0; b < 2; ++b)
#pragma unroll
            for (int m = 0; m < 4; ++m)
#pragma unroll
                for (int n = 0; n < 2; ++n) acc[a][b][m][n] = (f32x4){0.f, 0.f, 0.f, 0.f};
    bf16x8 At[4][2], B0[2][2], B1[2][2];
    const char* cA = (const char*)g.A + (size_t)cur.pm * tstep; const char* cB = (const char*)g.Bt + (size_t)cur.pn * tstep;
    S.a_ready(cur);
    if constexpr (SP2) {
        PG8_STAGE(PG8_SB(0, 0), cB, voffB); PG8_STAGE(PG8_SB(0, 1), cB + hstep, voffB); PG8_STAGE(PG8_SA(0, 0), cA, voffA); PG8_STAGE(PG8_SA(0, 1), cA + hstep, voffA);
        if (wr == 1) PG8_BAR;
        PG8_WAIT_V(2); PG8_BAR;
        PG8_STAGE(PG8_SB(1, 0), cB + kstep, voffB); PG8_STAGE(PG8_SA(1, 0), cA + kstep, voffA); PG8_STAGE(PG8_SB(1, 1), cB + hstep + kstep, voffB);
        PG8_WAIT_V(6); PG8_BAR;
    } else {
        PG8_STAGE(PG8_SB(0, 0), cB, voffB); PG8_STAGE(PG8_SA(0, 0), cA, voffA); PG8_STAGE(PG8_SB(0, 1), cB + hstep, voffB); PG8_STAGE(PG8_SA(0, 1), cA + hstep, voffA);
        if (wr == 1) PG8_BAR;
        PG8_WAIT_V(4); PG8_BAR;
        PG8_STAGE(PG8_SB(1, 0), cB + kstep, voffB); PG8_STAGE(PG8_SA(1, 0), cA + kstep, voffA); PG8_STAGE(PG8_SB(1, 1), cB + hstep + kstep, voffB);
        PG8_WAIT_V(6); PG8_BAR;
    }
    for (;;) {
        const bool has_next = S.next(ui + 1, nxt);
        const char* nA = has_next ? (const char*)g.A + (size_t)nxt.pm * tstep : cA; const char* nB = has_next ? (const char*)g.Bt + (size_t)nxt.pn * tstep : cB;
        if constexpr (Epi::HAS_MID) {
            for (int t = 0; t < 4; t += 2) PG8_KBODY();
            E.mid(acc, cur, wr, wc, fr, fq, 0);
            for (int t = 4; t < 8; t += 2) PG8_KBODY();
            E.mid(acc, cur, wr, wc, fr, fq, 1);
            for (int t = 8; t < nt; t += 2) PG8_KBODY();
        } else {
            for (int t = 0; t < nt; t += 2) PG8_KBODY();
        }
        if constexpr (ALIGN_EPI) { if (wr == 0) PG8_BAR; }
        if constexpr (!Epi::AFTER_DRAIN) { E(acc, cur, wr, wc, fr, fq); S.done(cur); }
        if (!has_next) break;
#pragma unroll
        for (int a = 0; a < 2; ++a)
#pragma unroll
            for (int b = 0; b < 2; ++b)
#pragma unroll
                for (int m = 0; m < 4; ++m)
#pragma unroll
                    for (int n = 0; n < 2; ++n) acc[a][b][m][n] = (f32x4){0.f, 0.f, 0.f, 0.f};
        cur = nxt; cA = nA; cB = nB; ++ui;
        if constexpr (ALIGN_EPI) { if (wr == 1) PG8_BAR; }
    }
    PG8_WAIT_V(0);
    if constexpr (!ALIGN_EPI) { if (wr == 0) PG8_BAR; }
    PG8_BAR;
#undef PG8_SA
#undef PG8_SB
#undef PG8_SBR
#undef PG8_STAGE
#undef PG8_LDA
#undef PG8_LDB
#undef PG8_MMA
#undef PG8_WAIT_V
#undef PG8_WAIT_L
#undef PG8_BAR
#undef PG8_SCHED
#undef PG8_KBODY
}
}

#define XB_TMO      128
#define XB_XCNT(j)  (256  + 64 * (j))
#define XB_XSUB(j)  (1280 + 64 * (j))
#define XB_XGEN(j)  (2304 + 64 * (j))
#define XB_TOP      3328
#define XB_TOPGEN   3392
#define XCD_BAR_WORDS 3456
#define XB_SPIN_CAP (1u << 18)
__device__ __forceinline__ unsigned xb_ld(unsigned* p)              { return __hip_atomic_load(p, __ATOMIC_RELAXED, __HIP_MEMORY_SCOPE_AGENT); }
__device__ __forceinline__ unsigned xb_add(unsigned* p, unsigned v) { return __hip_atomic_fetch_add(p, v, __ATOMIC_RELAXED, __HIP_MEMORY_SCOPE_AGENT); }
__device__ __forceinline__ unsigned xb_xcc_id() { return (unsigned)__builtin_amdgcn_s_getreg((3 << 11) | 20) & 0xFu; }
#define XB_SPIN(cond, bar) do { unsigned _sp = 0; while (cond) { __builtin_amdgcn_s_sleep(1); \
    if ((++_sp & 255u) == 0u) { if (xb_ld(&(bar)[XB_TMO])) break; if (_sp > XB_SPIN_CAP) { atomicAdd(&(bar)[XB_TMO], 1u); break; } } } } while (0)
struct XcdBarrier { unsigned* bar; unsigned x; volatile LAS unsigned* st; };
__device__ __forceinline__ XcdBarrier xcd_barrier_post(unsigned* bar, volatile LAS unsigned* st) {
    XcdBarrier b; b.bar = bar; b.x = xb_xcc_id(); b.st = st;
    if (threadIdx.x == 0) (void)xb_add(&bar[XB_XCNT(b.x)], 1u);
    return b;
}
__device__ __forceinline__ void xcd_barrier_complete(unsigned* bar, unsigned x, unsigned& nloc, unsigned& nx) {
    const unsigned G = gridDim.x * gridDim.y * gridDim.z;
    unsigned sum, cnt, mine = 0u, sp = 0u;
    for (;;) {
        sum = 0u; cnt = 0u;
#pragma unroll 1
        for (unsigned j = 0; j < 16; ++j) { const unsigned c = xb_ld(&bar[XB_XCNT(j)]); sum += c; cnt += (c > 0u) ? 1u : 0u; }
        mine = xb_ld(&bar[XB_XCNT(x)]);
        if (sum == G) break;
        __builtin_amdgcn_s_sleep(1);
        if ((++sp & 255u) == 0u) { if (xb_ld(&bar[XB_TMO])) break; if (sp > XB_SPIN_CAP) { atomicAdd(&bar[XB_TMO], 1u); break; } }
    }
    nloc = mine > 0u ? mine : 1u; nx = cnt > 0u ? cnt : 1u;
}
__device__ __forceinline__ void xcd_barrier(const XcdBarrier& b) {
    asm volatile("s_waitcnt vmcnt(0)" ::: "memory");
    __syncthreads();
    if (threadIdx.x == 0) {
        unsigned* bar = b.bar;
        __builtin_amdgcn_s_waitcnt(0);
        unsigned nloc = b.st[0], nx = b.st[1];
        if (nloc == 0u) { xcd_barrier_complete(bar, b.x, nloc, nx); b.st[0] = nloc; b.st[1] = nx; }
        const unsigned old = xb_add(&bar[XB_XSUB(b.x)], 1u);
        const unsigned gen = old / nloc;
        if (old + 1u == (gen + 1u) * nloc) {
            __builtin_amdgcn_fence(__ATOMIC_RELEASE, "agent");
            asm volatile("s_waitcnt vmcnt(0)" ::: "memory");
            const unsigned og = xb_add(&bar[XB_TOP], 1u);
            const unsigned tg = og / nx;
            if (og + 1u == (tg + 1u) * nx) xb_add(&bar[XB_TOPGEN], 1u);
            else XB_SPIN(xb_ld(&bar[XB_TOPGEN]) == tg, bar);
            __builtin_amdgcn_fence(__ATOMIC_ACQUIRE, "agent");
            xb_add(&bar[XB_XGEN(b.x)], 1u);
            asm volatile("s_waitcnt vmcnt(0)" ::: "memory");
        } else {
            XB_SPIN(xb_ld(&bar[XB_XGEN(b.x)]) == gen, bar);
            __builtin_amdgcn_fence(__ATOMIC_ACQUIRE, "agent");
            asm volatile("s_waitcnt vmcnt(0)" ::: "memory");
        }
    }
    __syncthreads();
}

constexpr int NWAVES = 8, NTHR = 512;
constexpr int RING_BYTES = 131072, LDSCTL_OFF = RING_BYTES, LDS_BYTES = 147456;

struct Args { const float* in[20]; float* out; unsigned char* ws; float inv[32]; int use_cg; int pad; };

struct LayerW {
    const float *bgate, *pool_w, *pool_scale, *sgu_g, *sgu_b_ln, *sgu_w, *sgu_b, *sinks, *ln_g, *ln_b;
    const float *state_pool, *cache_k, *cache_v;
    const bf16_t *Win_t, *Wp_t, *Wout_t, *PWT;
};

__device__ __forceinline__ int win_rowmap(int ncol) {
    if (ncol < C_Q || ncol >= C_VV) return ncol;
    const int hb = ncol & ~63, d = ncol & 63, nn = d >> 5, r = d & 31;
    return hb + 32 * (r >> 4) + 8 * ((r >> 2) & 3) + 4 * nn + (r & 3);
}
template <bool MAP>
__device__ __forceinline__ void p0_transpose_item(const float* W, int N, bf16_t* WT, int ldt, int koff, LAS float* scr, int item, int lane) {
    const int nblk = N / 32, kb = item / nblk, nb = item % nblk, k0 = 64 * kb, n0 = 32 * nb;
#pragma unroll 8
    for (int i = 0; i < 32; ++i) { const int kk = 2 * i + (lane >> 5); scr[kk * 33 + (lane & 31)] = W[(size_t)(k0 + kk) * N + n0 + (lane & 31)]; }
    asm volatile("s_waitcnt lgkmcnt(0)" ::: "memory");
    const int c = lane & 7;
#pragma unroll
    for (int j = 0; j < 4; ++j) { const int n = (lane >> 3) + 8 * j; const LAS float* s = scr + (8 * c) * 33 + n;
        u32x4 o; o.x = cvt_pk_bf16(s[0 * 33], s[1 * 33]); o.y = cvt_pk_bf16(s[2 * 33], s[3 * 33]); o.z = cvt_pk_bf16(s[4 * 33], s[5 * 33]); o.w = cvt_pk_bf16(s[6 * 33], s[7 * 33]);
        const int nr = MAP ? win_rowmap(n0 + n) : (n0 + n);
        *(u32x4*)(WT + (size_t)nr * ldt + koff + k0 + 8 * c) = o; }
    asm volatile("s_waitcnt lgkmcnt(0)" ::: "memory");
}
__device__ __forceinline__ void sincos_acc(float ang, float& s, float& c) {
    const double a = (double)ang;
    const double kq = rint(a * 0.63661977236758134308);
    const double r = fma(-kq, 1.57079632679489661923, a) - kq * 6.123233995736766e-17;
    const double r2 = r * r;
    double sp = -7.647163731819816e-13; sp = sp * r2 + 1.605904383682161e-10; sp = sp * r2 - 2.505210838544172e-08; sp = sp * r2 + 2.755731922398589e-06;
    sp = sp * r2 - 1.984126984126984e-04; sp = sp * r2 + 8.333333333333333e-03; sp = sp * r2 - 1.666666666666667e-01; sp = r + r * r2 * sp;
    double cp = 4.779477332387385e-14; cp = cp * r2 - 1.147074559772972e-11; cp = cp * r2 + 2.087675698786810e-09; cp = cp * r2 - 2.755731922398589e-07;
    cp = cp * r2 + 2.480158730158730e-05; cp = cp * r2 - 1.388888888888889e-03; cp = cp * r2 + 4.166666666666666e-02; cp = cp * r2 - 0.5; cp = 1.0 + r2 * cp;
    const int q = ((int)kq) & 3;
    const double ss = (q == 0) ? sp : (q == 1) ? cp : (q == 2) ? -sp : -cp;
    const double cc = (q == 0) ? cp : (q == 1) ? -sp : (q == 2) ? -cp : sp;
    s = (float)ss; c = (float)cc;
}

constexpr int KL_STRIDE = 144, VT_STRIDE = 520, KL_BYTES = 256 * KL_STRIDE, VT_OFF = KL_BYTES;
__device__ __forceinline__ void att_unit(LAS unsigned char* sm, int b, int n, int kvh, const bf16_t* H1, bf16_t* G, const float* sinks, float* outK, float* outV) {
    const int tid = opaque_tid(), lane = tid & 63, wave = __builtin_amdgcn_readfirstlane(tid >> 6), r32 = lane & 31, hi = lane >> 5;
    const int m0 = b * SEQ + n * 128;
    for (int c = tid; c < 2048; c += NTHR) {
        const int key = c >> 3, ch = c & 7;
        u32x4 kv = (u32x4){0u, 0u, 0u, 0u}, vv = (u32x4){0u, 0u, 0u, 0u};
        if (!(n == 0 && key < 128)) {
            const bf16_t* rp = H1 + (size_t)(m0 - 128 + key) * H1W;
            kv = *(const u32x4*)(rp + C_K + kvh * 64 + ch * 8);
            vv = *(const u32x4*)(rp + C_VV + kvh * 64 + ch * 8);
        }
        *(LAS u32x4*)(sm + key * KL_STRIDE + ch * 16) = kv;
        LAS bf16_t* vt = (LAS bf16_t*)(sm + VT_OFF) + (ch * 8) * (VT_STRIDE / 2) + key;
        vt[0 * (VT_STRIDE / 2)] = (bf16_t)(vv.x & 0xffffu); vt[1 * (VT_STRIDE / 2)] = (bf16_t)(vv.x >> 16);
        vt[2 * (VT_STRIDE / 2)] = (bf16_t)(vv.y & 0xffffu); vt[3 * (VT_STRIDE / 2)] = (bf16_t)(vv.y >> 16);
        vt[4 * (VT_STRIDE / 2)] = (bf16_t)(vv.z & 0xffffu); vt[5 * (VT_STRIDE / 2)] = (bf16_t)(vv.z >> 16);
        vt[6 * (VT_STRIDE / 2)] = (bf16_t)(vv.w & 0xffffu); vt[7 * (VT_STRIDE / 2)] = (bf16_t)(vv.w >> 16);
        if (outK != nullptr && n == 15 && key >= 128) {
            const size_t o = ((size_t)(b * 128 + key - 128) * 2 + kvh) * 64 + ch * 8;
            *(f32x4*)(outK + o) = (f32x4){bf_lo(kv.x), bf_hi(kv.x), bf_lo(kv.y), bf_hi(kv.y)}; *(f32x4*)(outK + o + 4) = (f32x4){bf_lo(kv.z), bf_hi(kv.z), bf_lo(kv.w), bf_hi(kv.w)};
            *(f32x4*)(outV + o) = (f32x4){bf_lo(vv.x), bf_hi(vv.x), bf_lo(vv.y), bf_hi(vv.y)}; *(f32x4*)(outV + o + 4) = (f32x4){bf_lo(vv.z), bf_hi(vv.z), bf_lo(vv.w), bf_hi(vv.w)};
        }
    }
    __syncthreads();
    const int hd = wave >> 1, ph = wave & 1, head = kvh * 4 + hd;
    const float sinkl = sinks[head] * LOG2E;
    const float C2 = 0.125f * LOG2E;
#pragma unroll 1
    for (int qi = 0; qi < 2; ++qi) {
        const int qt = 2 * ph + qi, p0 = 32 * qt;
        const bf16_t* qrow = H1 + (size_t)(m0 + p0 + r32) * H1W;
        bf16x8 qf[4];
#pragma unroll
        for (int d0 = 0; d0 < 4; ++d0) qf[d0] = *(const bf16x8*)(qrow + C_Q + head * 64 + d0 * 16 + hi * 8);
        f32x16 s[5];
#pragma unroll
        for (int j = 0; j < 5; ++j) {
            const int kt = qt + j;
            f32x16 a = {};
            const LAS unsigned char* kb = sm + (32 * kt + r32) * KL_STRIDE + hi * 16;
#pragma unroll
            for (int d0 = 0; d0 < 4; ++d0) { const bf16x8 kf = *(const LAS bf16x8*)(kb + d0 * 32); a = __builtin_amdgcn_mfma_f32_32x32x16_bf16(kf, qf[d0], a, 0, 0, 0); }
            const bool dead = (n == 0) && (kt < 4);
#pragma unroll
            for (int r = 0; r < 16; ++r) {
                const int jj = (r & 3) + 8 * (r >> 2) + 4 * hi;
                bool ok = !dead;
                if (j == 0) ok = ok && (jj >= r32);
                if (j == 4) ok = ok && (jj <= r32);
                a[r] = ok ? a[r] * C2 : -INFINITY;
            }
            s[j] = a;
        }
        float mx = -INFINITY;
#pragma unroll
        for (int j = 0; j < 5; ++j)
#pragma unroll
            for (int r = 0; r < 16; ++r) mx = fmaxf(mx, s[j][r]);
        mx = fmaxf(mx, __shfl_xor(mx, 32));
        mx = fmaxf(mx, sinkl);
        float lsum = 0.f;
#pragma unroll
        for (int j = 0; j < 5; ++j)
#pragma unroll
            for (int r = 0; r < 16; ++r) { const float p = __builtin_amdgcn_exp2f(s[j][r] - mx); s[j][r] = p; lsum += p; }
        lsum += __shfl_xor(lsum, 32);
        lsum += __builtin_amdgcn_exp2f(sinkl - mx);
        const float inv = 1.0f / lsum;
        f32x16 o[2]; o[0] = f32x16{}; o[1] = f32x16{};
#pragma unroll
        for (int j = 0; j < 5; ++j) {
            const int kt = qt + j;
#pragma unroll
            for (int s2 = 0; s2 < 2; ++s2) {
                u32x4 pw; pw.x = cvt_pk_bf16(s[j][8 * s2 + 0], s[j][8 * s2 + 1]); pw.y = cvt_pk_bf16(s[j][8 * s2 + 2], s[j][8 * s2 + 3]);
                pw.z = cvt_pk_bf16(s[j][8 * s2 + 4], s[j][8 * s2 + 5]); pw.w = cvt_pk_bf16(s[j][8 * s2 + 6], s[j][8 * s2 + 7]);
                const bf16x8 pf = __builtin_bit_cast(bf16x8, pw);
#pragma unroll
                for (int mt = 0; mt < 2; ++mt) {
                    const LAS unsigned char* vp = sm + VT_OFF + (32 * mt + r32) * VT_STRIDE + (32 * kt + 16 * s2 + 4 * hi) * 2;
                    const u32x2 v0 = *(const LAS u32x2*)vp, v1 = *(const LAS u32x2*)(vp + 16);
                    u32x4 vw; vw.x = v0.x; vw.y = v0.y; vw.z = v1.x; vw.w = v1.y;
                    o[mt] = __builtin_amdgcn_mfma_f32_32x32x16_bf16(__builtin_bit_cast(bf16x8, vw), pf, o[mt], 0, 0, 0);
                }
            }
        }
        bf16_t* grow = G + (size_t)(m0 + p0 + r32) * DM + 512 + head * 64;
#pragma unroll
        for (int mt = 0; mt < 2; ++mt)
#pragma unroll
            for (int g4 = 0; g4 < 4; ++g4) {
                const int dd = 32 * mt + 8 * g4 + 4 * hi;
                const u32x2 z = *(const u32x2*)(qrow + C_ZC + head * 64 + dd);
                const float y0 = o[mt][4 * g4 + 0] * inv * siluf_(bf_lo(z.x)), y1 = o[mt][4 * g4 + 1] * inv * siluf_(bf_hi(z.x));
                const float y2 = o[mt][4 * g4 + 2] * inv * siluf_(bf_lo(z.y)), y3 = o[mt][4 * g4 + 3] * inv * siluf_(bf_hi(z.y));
                u32x2 w; w.x = cvt_pk_bf16(y0, y1); w.y = cvt_pk_bf16(y2, y3);
                *(u32x2*)(grow + dd) = w;
            }
    }
    __syncthreads();
}

constexpr int VNT_STRIDE = 272;
__device__ __forceinline__ void sgu_unit(LAS unsigned char* sm, int b, int n, const bf16_t* H1, bf16_t* G, const LayerW& L) {
    const int tid = opaque_tid(), lane = tid & 63, wave = __builtin_amdgcn_readfirstlane(tid >> 6), r32 = lane & 31, hi = lane >> 5;
    const int m0 = b * SEQ + n * 128;
    {
        const f32x4 g4 = *(const f32x4*)(L.sgu_g + 4 * lane), b4 = *(const f32x4*)(L.sgu_b_ln + 4 * lane);
#pragma unroll 4
        for (int i = 0; i < 16; ++i) {
            const int t = wave * 16 + i;
            const u32x2 w = *(const u32x2*)(H1 + (size_t)(m0 + t) * H1W + C_V + 4 * lane);
            f32x4 x = (f32x4){bf_lo(w.x), bf_hi(w.x), bf_lo(w.y), bf_hi(w.y)};
            const float mean = wave_sum((x[0] + x[1]) + (x[2] + x[3])) * (1.f / 256.f);
            x = x - mean;
            const float var = wave_sum((x[0] * x[0] + x[1] * x[1]) + (x[2] * x[2] + x[3] * x[3])) * (1.f / 256.f);
            const float rstd = 1.0f / sqrtf(var + LN_EPS);
            x = x * rstd * g4 + b4;
            const unsigned p01 = cvt_pk_bf16(x[0], x[1]), p23 = cvt_pk_bf16(x[2], x[3]);
            LAS bf16_t* vp = (LAS bf16_t*)(sm + (4 * lane) * VNT_STRIDE) + t;
            vp[0] = (bf16_t)(p01 & 0xffffu); vp[VNT_STRIDE / 2] = (bf16_t)(p01 >> 16); vp[2 * (VNT_STRIDE / 2)] = (bf16_t)(p23 & 0xffffu); vp[3 * (VNT_STRIDE / 2)] = (bf16_t)(p23 >> 16);
        }
    }
    __syncthreads();
    const int g = wave >> 1, th = wave & 1;
#pragma unroll 1
    for (int ti = 0; ti < 2; ++ti) {
        const int tt = (ti == 0) ? th : 3 - th;
        const int t = 32 * tt + r32;
        f32x16 acc[2]; acc[0] = f32x16{}; acc[1] = f32x16{};
        const float* wrow = L.sgu_w + ((size_t)g * 128 + t) * 128;
        const int nks = 2 * (tt + 1);
#pragma unroll 1
        for (int ks = 0; ks < nks; ++ks) {
            const int s0 = 16 * ks + 8 * hi;
            const f32x4 w0 = *(const f32x4*)(wrow + s0), w1 = *(const f32x4*)(wrow + s0 + 4);
            u32x4 bw;
            bw.x = cvt_pk_bf16((s0 + 0 <= t) ? w0[0] : 0.f, (s0 + 1 <= t) ? w0[1] : 0.f); bw.y = cvt_pk_bf16((s0 + 2 <= t) ? w0[2] : 0.f, (s0 + 3 <= t) ? w0[3] : 0.f);
            bw.z = cvt_pk_bf16((s0 + 4 <= t) ? w1[0] : 0.f, (s0 + 5 <= t) ? w1[1] : 0.f); bw.w = cvt_pk_bf16((s0 + 6 <= t) ? w1[2] : 0.f, (s0 + 7 <= t) ? w1[3] : 0.f);
            const bf16x8 bf = __builtin_bit_cast(bf16x8, bw);
#pragma unroll
            for (int ct = 0; ct < 2; ++ct) {
                const bf16x8 af = *(const LAS bf16x8*)(sm + (g * 64 + 32 * ct + r32) * VNT_STRIDE + s0 * 2);
                acc[ct] = __builtin_amdgcn_mfma_f32_32x32x16_bf16(af, bf, acc[ct], 0, 0, 0);
            }
        }
        const float sb = L.sgu_b[g * 128 + t];
        const bf16_t* hrow = H1 + (size_t)(m0 + t) * H1W;
        bf16_t* grow = G + (size_t)(m0 + t) * DM + 256 + g * 64;
#pragma unroll
        for (int ct = 0; ct < 2; ++ct)
#pragma unroll
            for (int g4 = 0; g4 < 4; ++g4) {
                const int c0 = 32 * ct + 8 * g4 + 4 * hi;
                const u32x2 uu = *(const u32x2*)(hrow + C_U + g * 64 + c0), zz = *(const u32x2*)(hrow + C_ZB + g * 64 + c0);
                const float y0 = bf_lo(uu.x) * (acc[ct][4 * g4 + 0] + sb) * siluf_(bf_lo(zz.x)), y1 = bf_hi(uu.x) * (acc[ct][4 * g4 + 1] + sb) * siluf_(bf_hi(zz.x));
                const float y2 = bf_lo(uu.y) * (acc[ct][4 * g4 + 2] + sb) * siluf_(bf_lo(zz.y)), y3 = bf_hi(uu.y) * (acc[ct][4 * g4 + 3] + sb) * siluf_(bf_hi(zz.y));
                u32x2 w; w.x = cvt_pk_bf16(y0, y1); w.y = cvt_pk_bf16(y2, y3);
                *(u32x2*)(grow + c0) = w;
            }
    }
    __syncthreads();
}

constexpr int XA_STRIDE = 528;
__device__ __forceinline__ void pool_unit(LAS unsigned char* sm, int b, int n, const bf16_t* H1, bf16_t* G, const LayerW& L, float* outP) {
    const int tid = opaque_tid(), lane = tid & 63, wave = __builtin_amdgcn_readfirstlane(tid >> 6), r32 = lane & 31, hi = lane >> 5;
    const int m0 = b * SEQ + n * 128;
    for (int c = tid; c < 143 * 32; c += NTHR) {
        const int i = c >> 5, ch = c & 31;
        u32x4 v = (u32x4){0u, 0u, 0u, 0u};
        if (!(n == 0 && i < 15)) v = *(const u32x4*)(H1 + (size_t)(m0 - 15 + i) * H1W + C_XA + ch * 8);
        *(LAS u32x4*)(sm + i * XA_STRIDE + ch * 16) = v;
        if (outP != nullptr && n == 15 && i >= 128) {
            const size_t o = ((size_t)b * 15 + (i - 128)) * 256 + ch * 8;
            *(f32x4*)(outP + o) = (f32x4){bf_lo(v.x), bf_hi(v.x), bf_lo(v.y), bf_hi(v.y)}; *(f32x4*)(outP + o + 4) = (f32x4){bf_lo(v.z), bf_hi(v.z), bf_lo(v.w), bf_hi(v.w)};
        }
    }
    __syncthreads();
    const int g = wave >> 1, th = wave & 1, wg = 2 << g;
#pragma unroll 1
    for (int ti = 0; ti < 2; ++ti) {
        const int tt = 2 * th + ti, t = 32 * tt + r32, pos = 128 * n + t;
        const float invc = 1.0f / (float)((pos + 1 < wg) ? (pos + 1) : wg);
        f32x16 acc[2]; acc[0] = f32x16{}; acc[1] = f32x16{};
#pragma unroll 1
        for (int ks = 0; ks < 4; ++ks) {
            const int c0 = g * 64 + 16 * ks + 8 * hi;
            const LAS unsigned char* xp = sm + (t + 15) * XA_STRIDE + c0 * 2;
            const u32x4 self = *(const LAS u32x4*)xp;
            float sum[8];
            sum[0] = bf_lo(self.x); sum[1] = bf_hi(self.x); sum[2] = bf_lo(self.y); sum[3] = bf_hi(self.y); sum[4] = bf_lo(self.z); sum[5] = bf_hi(self.z); sum[6] = bf_lo(self.w); sum[7] = bf_hi(self.w);
#pragma unroll 1
            for (int jj = 1; jj < wg; ++jj) {
                const u32x4 v = *(const LAS u32x4*)(xp - jj * XA_STRIDE);
                sum[0] += bf_lo(v.x); sum[1] += bf_hi(v.x); sum[2] += bf_lo(v.y); sum[3] += bf_hi(v.y); sum[4] += bf_lo(v.z); sum[5] += bf_hi(v.z); sum[6] += bf_lo(v.w); sum[7] += bf_hi(v.w);
            }
            u32x4 pw;
            pw.x = cvt_pk_bf16(sum[0] * invc - bf_lo(self.x), sum[1] * invc - bf_hi(self.x)); pw.y = cvt_pk_bf16(sum[2] * invc - bf_lo(self.y), sum[3] * invc - bf_hi(self.y));
            pw.z = cvt_pk_bf16(sum[4] * invc - bf_lo(self.z), sum[5] * invc - bf_hi(self.z)); pw.w = cvt_pk_bf16(sum[6] * invc - bf_lo(self.w), sum[7] * invc - bf_hi(self.w));
            const bf16x8 pf = __builtin_bit_cast(bf16x8, pw);
#pragma unroll
            for (int dt = 0; dt < 2; ++dt) {
                const bf16x8 af = *(const bf16x8*)(L.PWT + ((size_t)(g * 64 + 32 * dt + r32)) * 64 + 16 * ks + 8 * hi);
                acc[dt] = __builtin_amdgcn_mfma_f32_32x32x16_bf16(af, pf, acc[dt], 0, 0, 0);
            }
        }
        const bf16_t* hrow = H1 + (size_t)(m0 + t) * H1W;
        bf16_t* grow = G + (size_t)(m0 + t) * DM + g * 64;
#pragma unroll
        for (int dt = 0; dt < 2; ++dt)
#pragma unroll
            for (int g4 = 0; g4 < 4; ++g4) {
                const int d0 = 32 * dt + 8 * g4 + 4 * hi;
                const f32x4 ps = *(const f32x4*)(L.pool_scale + g * 64 + d0);
                const u32x2 zz = *(const u32x2*)(hrow + C_ZA + g * 64 + d0);
                const float y0 = acc[dt][4 * g4 + 0] * ps[0] * siluf_(bf_lo(zz.x)), y1 = acc[dt][4 * g4 + 1] * ps[1] * siluf_(bf_hi(zz.x));
                const float y2 = acc[dt][4 * g4 + 2] * ps[2] * siluf_(bf_lo(zz.y)), y3 = acc[dt][4 * g4 + 3] * ps[3] * siluf_(bf_hi(zz.y));
                u32x2 w; w.x = cvt_pk_bf16(y0, y1); w.y = cvt_pk_bf16(y2, y3);
                *(u32x2*)(grow + d0) = w;
            }
    }
    __syncthreads();
}

__device__ __forceinline__ void sample_unit(LAS unsigned char* sm, int bs, const bf16_t* H1, bf16_t* G, const LayerW& L, float* outPoolS, float* outKS, float* outVS, float* outCV) {
    const int tid = opaque_tid(), lane = tid & 63, wave = __builtin_amdgcn_readfirstlane(tid >> 6);
    const int m = MP + bs;
    LAS float* hrow = (LAS float*)sm;
    LAS float* pl = hrow + 2560;
    LAS float* sc = pl + 256;
    for (int c = tid; c < H1W; c += NTHR) hrow[c] = bf2f(H1[(size_t)m * H1W + c]);
    __syncthreads();
    bf16_t* grow = G + (size_t)m * DM;
    if (tid < 256) {
        const int g = tid >> 6, wg = 2 << g;
        const float xa = hrow[C_XA + tid];
        float s = xa;
        const float* pb = L.state_pool + (size_t)bs * 15 * 256 + tid;
        for (int j = 0; j < wg - 1; ++j) s += pb[(size_t)(14 - j) * 256];
        pl[tid] = s / (float)wg - xa;
        outPoolS[((size_t)bs * 15 + 14) * 256 + tid] = xa;
    } else {
        const int ch = tid - 256, g = ch >> 6;
        const f32x4 xv = *(const LAS f32x4*)(hrow + C_V + 4 * lane);
        const float mean = wave_sum((xv[0] + xv[1]) + (xv[2] + xv[3])) * (1.f / 256.f);
        const f32x4 dv = xv - mean;
        const float var = wave_sum((dv[0] * dv[0] + dv[1] * dv[1]) + (dv[2] * dv[2] + dv[3] * dv[3])) * (1.f / 256.f);
        const float rstd = 1.0f / sqrtf(var + LN_EPS);
        const float vn = (hrow[C_V + ch] - mean) * rstd * L.sgu_g[ch] + L.sgu_b_ln[ch];
        outCV[(size_t)bs * 256 + ch] = vn;
        const float sv = L.sgu_w[(size_t)g * 128 * 128] * vn + L.sgu_b[g * 128];
        const float yb = hrow[C_U + ch] * sv * siluf_(hrow[C_ZB + ch]);
        grow[256 + ch] = (bf16_t)(cvt_pk_bf16(yb, 0.f) & 0xffffu);
    }
    {
        const int key = tid & 127, hq = tid >> 7, kvh = hq >> 1;
        const float* kp = L.cache_k + (((size_t)bs * 128 + key) * 2 + kvh) * 64;
        const LAS float* q0 = hrow + C_Q + (2 * hq) * 64; const LAS float* q1 = q0 + 64;
        float s0 = 0.f, s1 = 0.f;
#pragma unroll 4
        for (int d = 0; d < 64; d += 4) { const f32x4 kv = *(const f32x4*)(kp + d);
            s0 += kv[0] * q0[d] + kv[1] * q0[d + 1] + kv[2] * q0[d + 2] + kv[3] * q0[d + 3];
            s1 += kv[0] * q1[d] + kv[1] * q1[d + 1] + kv[2] * q1[d + 2] + kv[3] * q1[d + 3]; }
        sc[(2 * hq) * 132 + key] = s0 * 0.125f; sc[(2 * hq + 1) * 132 + key] = s1 * 0.125f;
        if (tid < 8) { const LAS float* q = hrow + C_Q + tid * 64; const LAS float* kn = hrow + C_K + (tid >> 2) * 64; float s = 0.f;
            for (int d = 0; d < 64; ++d) s += q[d] * kn[d];
            sc[tid * 132 + 128] = s * 0.125f; }
        if (tid < 128) { outKS[((size_t)bs * 128 + 127) * 128 + tid] = hrow[C_K + tid]; outVS[((size_t)bs * 128 + 127) * 128 + tid] = hrow[C_VV + tid]; }
    }
    __syncthreads();
    if (tid < 256) {
        const int g = tid >> 6, d = tid & 63;
        const float* pw = L.pool_w + (size_t)g * 64 * 64 + d;
        float s = 0.f;
#pragma unroll 8
        for (int c = 0; c < 64; ++c) s += pl[g * 64 + c] * pw[(size_t)c * 64];
        const float ya = s * L.pool_scale[tid] * siluf_(hrow[C_ZA + tid]);
        grow[tid] = (bf16_t)(cvt_pk_bf16(ya, 0.f) & 0xffffu);
    }
    {
        const int hd = wave;
        const float a0 = sc[hd * 132 + lane], a1 = sc[hd * 132 + 64 + lane], a2 = (lane == 0) ? sc[hd * 132 + 128] : -INFINITY;
        const float sink = L.sinks[hd];
        const float mx = fmaxf(wave_max(fmaxf(fmaxf(a0, a1), a2)), sink);
        const float p0 = __expf(a0 - mx), p1 = __expf(a1 - mx), p2 = (lane == 0) ? __expf(a2 - mx) : 0.f;
        const float den = wave_sum(p0 + p1 + p2) + __expf(sink - mx);
        const float inv = 1.0f / den;
        sc[hd * 132 + lane] = p0 * inv; sc[hd * 132 + 64 + lane] = p1 * inv; if (lane == 0) sc[hd * 132 + 128] = p2 * inv;
    }
    __syncthreads();
    {
        const int hd = wave, kvh = hd >> 2, d = lane;
        const float* vp = L.cache_v + ((size_t)bs * 128 * 2 + kvh) * 64 + d;
        float o = 0.f;
#pragma unroll 8
        for (int key = 0; key < 128; ++key) o += sc[hd * 132 + key] * vp[(size_t)key * 128];
        o += sc[hd * 132 + 128] * hrow[C_VV + kvh * 64 + d];
        const float yc = o * siluf_(hrow[C_ZC + hd * 64 + d]);
        grow[512 + hd * 64 + d] = (bf16_t)(cvt_pk_bf16(yc, 0.f) & 0xffffu);
    }
    __syncthreads();
}

__device__ __forceinline__ void ln_rows(const float* T, const float* lg, const float* lb, bf16_t* X1, float* out, int layer, int bid, int ngw) {
    const int tid = opaque_tid(), lane = tid & 63, gw = bid * NWAVES + __builtin_amdgcn_readfirstlane(tid >> 6);
    f32x4 g4[4], b4[4];
#pragma unroll
    for (int j = 0; j < 4; ++j) { g4[j] = *(const f32x4*)(lg + 4 * lane + 256 * j); b4[j] = *(const f32x4*)(lb + 4 * lane + 256 * j); }
    for (int row = gw; row < MREAL; row += ngw) {
        const float* tr = T + (size_t)row * DM + 4 * lane;
        f32x4 v[4]; float s = 0.f;
#pragma unroll
        for (int j = 0; j < 4; ++j) { v[j] = *(const f32x4*)(tr + 256 * j); s += (v[j][0] + v[j][1]) + (v[j][2] + v[j][3]); }
        const float mean = wave_sum(s) * (1.f / DM); float s2 = 0.f;
#pragma unroll
        for (int j = 0; j < 4; ++j) { v[j] = v[j] - mean; s2 += (v[j][0] * v[j][0] + v[j][1] * v[j][1]) + (v[j][2] * v[j][2] + v[j][3] * v[j][3]); }
        const float rstd = 1.0f / sqrtf(wave_sum(s2) * (1.f / DM) + LN_EPS);
        if (layer == 0) {
            bf16_t* xo = X1 + (size_t)row * DM + 4 * lane;
#pragma unroll
            for (int j = 0; j < 4; ++j) { const f32x4 y = v[j] * rstd * g4[j] + b4[j]; u32x2 w; w.x = cvt_pk_bf16(y[0], y[1]); w.y = cvt_pk_bf16(y[2], y[3]); *(u32x2*)(xo + 256 * j) = w; }
        } else {
            float* yo = (row < MP ? out + O_YP + (size_t)row * DM : out + O_YS + (size_t)(row - MP) * DM) + 4 * lane;
#pragma unroll
            for (int j = 0; j < 4; ++j) *(f32x4*)(yo + 256 * j) = v[j] * rstd * g4[j] + b4[j];
        }
    }
}

typedef const Args __attribute__((address_space(4)))* KArgsP;
__device__ __forceinline__ KArgsP kargs() { KArgsP p = (KArgsP)__builtin_amdgcn_kernarg_segment_ptr(); asm volatile("" : "+s"(p)); return p; }

__global__ void __launch_bounds__(NTHR, 2) mk_fwd(Args args) {
    __shared__ __attribute__((aligned(16))) unsigned char smem[LDS_BYTES];
    LAS unsigned char* lds = (LAS unsigned char*)smem;
    const int G = gridDim.x, bid = blockIdx.x;
    for (int u = threadIdx.x; u < (LDS_BYTES - LDSCTL_OFF) / 4; u += NTHR) ((LAS unsigned*)(lds + LDSCTL_OFF))[u] = 0u;
    __syncthreads();
    XcdBarrier bar = xcd_barrier_post((unsigned*)(args.ws + WS_CTL) + 1024, (volatile LAS unsigned*)(lds + LDSCTL_OFF + 64));
#ifdef USE_CG_SYNC
#define GRID_BAR() cg::this_grid().sync()
#else
#define GRID_BAR() xcd_barrier(bar)
#endif
    const int ngw = G * NWAVES;

    {
        KArgsP ap = kargs();
        unsigned char* ws = ap->ws; float* out = ap->out;
        float* ropec = (float*)(ws + WS_ROPE); float* ropes = ropec + ROPE_N;
        bf16_t* PWT = (bf16_t*)(ws + WS_PWT);
        bf16_t* WIN = (bf16_t*)(ws + WS_WIN); bf16_t* WP = (bf16_t*)(ws + WS_WP); bf16_t* WOUT = (bf16_t*)(ws + WS_WOUT);
        bf16_t* XG = (bf16_t*)out;
        const float* x_prompt = ap->in[0]; const float* x_sample = ap->in[1];
        const int tid = opaque_tid(), lane = tid & 63, wave = __builtin_amdgcn_readfirstlane(tid >> 6), gw = bid * NWAVES + wave;
        LAS float* scr = (LAS float*)(lds + wave * 16384);
        for (int it = gw; it < 2 * 3840; it += ngw) {
            const int l = it / 3840; int r = it % 3840;
            if (r < 2816) { p0_transpose_item<true>(ap->in[5] + (size_t)l * DM * DIN, DIN, WIN + (size_t)l * DIN * DM, DM, 0, scr, r, lane); continue; } r -= 2816;
            if (r < 128) { p0_transpose_item<false>(ap->in[14] + (size_t)l * 256 * DM, DM, WP + (size_t)l * DM * DM, DM, 0, scr, r, lane); continue; } r -= 128;
            if (r < 128) { p0_transpose_item<false>(ap->in[15] + (size_t)l * 256 * DM, DM, WP + (size_t)l * DM * DM, DM, 256, scr, r, lane); continue; } r -= 128;
            if (r < 256) { p0_transpose_item<false>(ap->in[16] + (size_t)l * 512 * DM, DM, WP + (size_t)l * DM * DM, DM, 512, scr, r, lane); continue; } r -= 256;
            p0_transpose_item<false>(ap->in[17] + (size_t)l * DM * DM, DM, WOUT + (size_t)l * DM * DM, DM, 0, scr, r, lane);
        }
        for (int row = gw; row < MPAD; row += ngw) {
            bf16_t* xo = XG + (size_t)row * DM + 4 * lane;
            if (row < MREAL) {
                const float* xr = (row < MP ? x_prompt + (size_t)row * DM : x_sample + (size_t)(row - MP) * DM) + 4 * lane;
#pragma unroll
                for (int j = 0; j < 4; ++j) { const f32x4 v = *(const f32x4*)(xr + 256 * j); u32x2 w; w.x = cvt_pk_bf16(v[0], v[1]); w.y = cvt_pk_bf16(v[2], v[3]); *(u32x2*)(xo + 256 * j) = w; }
            } else {
#pragma unroll
                for (int j = 0; j < 4; ++j) *(u32x2*)(xo + 256 * j) = (u32x2){0u, 0u};
            }
        }
        const int gt = bid * NTHR + tid, ngt = G * NTHR;
        for (int e = gt; e < ROPE_N; e += ngt) { const int pi = e >> 5, i = e & 31; const float pos = (pi < 2048) ? (float)pi : 8192.0f; const float ang = pos * ap->inv[i];
            float s, c; sincos_acc(ang, s, c); ropec[e] = c; ropes[e] = s; }
        for (int e = gt; e < 2 * 4 * 64 * 64; e += ngt) { const int c = e & 63, d = (e >> 6) & 63, lg = e >> 12;
            PWT[e] = (bf16_t)(cvt_pk_bf16(ap->in[7][((size_t)lg * 64 + c) * 64 + d], 0.f) & 0xffffu); }
        for (int e = gt; e < 2 * 128 * 127 * 32; e += ngt) { const int q = e % (127 * 32), lb = e / (127 * 32);
            const size_t so = ((size_t)lb * 128 + 1) * 128 + (size_t)q * 4, dof = (size_t)lb * 128 * 128 + (size_t)q * 4;
            *(f32x4*)(out + O_KS + dof) = *(const f32x4*)(ap->in[3] + so); *(f32x4*)(out + O_VS + dof) = *(const f32x4*)(ap->in[4] + so); }
        for (int e = gt; e < 2 * 128 * 14 * 64; e += ngt) { const int q = e % (14 * 64), lb = e / (14 * 64);
            *(f32x4*)(out + O_POOLS + (size_t)lb * 15 * 256 + (size_t)q * 4) = *(const f32x4*)(ap->in[2] + ((size_t)lb * 15 + 1) * 256 + (size_t)q * 4); }
    }
    GRID_BAR();

    {
#ifndef NO_P1
        {
            KArgsP ap = kargs(); unsigned char* ws = ap->ws;
            const bf16_t* Xin = (0 == 0) ? (const bf16_t*)ap->out : (const bf16_t*)(ws + WS_X1);
            pg8::Gemm g{Xin, (const bf16_t*)(ws + WS_WIN) + (size_t)0 * DIN * DM, MPAD, DIN, DM}; pg8::StaticOrder S; S.init(MPAD, DIN, G, bid);
            pg8::EpiInProj E{(bf16_t*)(ws + WS_H1), (bf16_t*)(ws + WS_GT), ap->in[6] + (size_t)0 * 3 * DM, (const float*)(ws + WS_ROPE), (const float*)(ws + WS_ROPE) + ROPE_N};
            pg8::gemm_phase<pg8::EpiInProj, pg8::StaticOrder, true, true>(lds, g, S, E);
        }
#endif
        GRID_BAR();
        {
            KArgsP ap = kargs(); unsigned char* ws = ap->ws; float* out = ap->out;
            const bf16_t* H1 = (const bf16_t*)(ws + WS_H1); bf16_t* XG = (bf16_t*)out;
            LayerW L;
            L.bgate = nullptr; L.pool_w = ap->in[7] + (size_t)0 * 4 * 64 * 64; L.pool_scale = ap->in[8] + (size_t)0 * 256;
            L.sgu_g = ap->in[9] + (size_t)0 * 256; L.sgu_b_ln = ap->in[10] + (size_t)0 * 256; L.sgu_w = ap->in[11] + (size_t)0 * 4 * 128 * 128; L.sgu_b = ap->in[12] + (size_t)0 * 4 * 128;
            L.sinks = ap->in[13] + (size_t)0 * 8; L.ln_g = nullptr; L.ln_b = nullptr;
            L.state_pool = ap->in[2] + (size_t)0 * 128 * 15 * 256; L.cache_k = ap->in[3] + (size_t)0 * 128 * 128 * 128; L.cache_v = ap->in[4] + (size_t)0 * 128 * 128 * 128;
            L.Win_t = nullptr; L.Wp_t = nullptr; L.Wout_t = nullptr; L.PWT = (const bf16_t*)(ws + WS_PWT) + (size_t)0 * 4 * 64 * 64;
            for (int ui = bid; ui < 640; ui += G) {
#ifndef NO_ATT
                if (ui < 256) { const int kvh = ui & 1, bn = ui >> 1; att_unit(lds, bn >> 4, bn & 15, kvh, H1, XG, L.sinks, out + O_KP + (size_t)0 * 8 * 128 * 128, out + O_VP + (size_t)0 * 8 * 128 * 128); }
                else
#endif
#ifndef NO_SGU
                if (ui < 384) { if (ui >= 256) { const int bn = ui - 256; sgu_unit(lds, bn >> 4, bn & 15, H1, XG, L); } }
                else
#endif
#ifndef NO_POOL
                if (ui < 512) { if (ui >= 384) { const int bn = ui - 384; pool_unit(lds, bn >> 4, bn & 15, H1, XG, L, out + O_POOLP + (size_t)0 * 8 * 15 * 256); } }
                else
#endif
#ifndef NO_SAMPLE
                if (ui >= 512) { const int bs = ui - 512; sample_unit(lds, bs, H1, XG, L, out + O_POOLS + (size_t)0 * 128 * 15 * 256, out + O_KS + (size_t)0 * 128 * 128 * 128, out + O_VS + (size_t)0 * 128 * 128 * 128, out + O_CVS + (size_t)0 * 128 * 256); }
#endif
                {}
            }
        }
        GRID_BAR();
#ifndef NO_P3
        {
            KArgsP ap = kargs(); unsigned char* ws = ap->ws;
            pg8::Gemm g{(const bf16_t*)ap->out, (const bf16_t*)(ws + WS_WP) + (size_t)0 * DM * DM, MPAD, DM, DM}; pg8::StaticOrder S; S.init(MPAD, DM, G, bid);
            pg8::EpiMerge E{(bf16_t*)(ws + WS_H1), (const bf16_t*)(ws + WS_GT)};
            pg8::gemm_phase<pg8::EpiMerge, pg8::StaticOrder, true, true>(lds, g, S, E);
        }
#endif
        GRID_BAR();
#ifndef NO_P4
        {
            KArgsP ap = kargs(); unsigned char* ws = ap->ws;
            pg8::Gemm g{(const bf16_t*)(ws + WS_H1), (const bf16_t*)(ws + WS_WOUT) + (size_t)0 * DM * DM, MPAD, DM, DM}; pg8::StaticOrder S; S.init(MPAD, DM, G, bid);
            pg8::EpiOut E{(float*)(ws + WS_GT), ap->in[0], ap->in[1], (const bf16_t*)(ws + WS_X1), 0};
            pg8::gemm_phase<pg8::EpiOut, pg8::StaticOrder, true, true>(lds, g, S, E);
        }
#endif
        GRID_BAR();
        {
            KArgsP ap = kargs(); unsigned char* ws = ap->ws;
            ln_rows((const float*)(ws + WS_GT), ap->in[18] + (size_t)0 * DM, ap->in[19] + (size_t)0 * DM, (bf16_t*)(ws + WS_X1), ap->out, 0, bid, ngw);
        }
        if (0 + 1 < DEPTH) GRID_BAR();
    }
    {
#ifndef NO_P1
        {
            KArgsP ap = kargs(); unsigned char* ws = ap->ws;
            const bf16_t* Xin = (1 == 0) ? (const bf16_t*)ap->out : (const bf16_t*)(ws + WS_X1);
            pg8::Gemm g{Xin, (const bf16_t*)(ws + WS_WIN) + (size_t)1 * DIN * DM, MPAD, DIN, DM}; pg8::StaticOrder S; S.init(MPAD, DIN, G, bid);
            pg8::EpiInProj E{(bf16_t*)(ws + WS_H1), (bf16_t*)(ws + WS_GT), ap->in[6] + (size_t)1 * 3 * DM, (const float*)(ws + WS_ROPE), (const float*)(ws + WS_ROPE) + ROPE_N};
            pg8::gemm_phase<pg8::EpiInProj, pg8::StaticOrder, true, true>(lds, g, S, E);
        }
#endif
        GRID_BAR();
        {
            KArgsP ap = kargs(); unsigned char* ws = ap->ws; float* out = ap->out;
            const bf16_t* H1 = (const bf16_t*)(ws + WS_H1); bf16_t* XG = (bf16_t*)out;
            LayerW L;
            L.bgate = nullptr; L.pool_w = ap->in[7] + (size_t)1 * 4 * 64 * 64; L.pool_scale = ap->in[8] + (size_t)1 * 256;
            L.sgu_g = ap->in[9] + (size_t)1 * 256; L.sgu_b_ln = ap->in[10] + (size_t)1 * 256; L.sgu_w = ap->in[11] + (size_t)1 * 4 * 128 * 128; L.sgu_b = ap->in[12] + (size_t)1 * 4 * 128;
            L.sinks = ap->in[13] + (size_t)1 * 8; L.ln_g = nullptr; L.ln_b = nullptr;
            L.state_pool = ap->in[2] + (size_t)1 * 128 * 15 * 256; L.cache_k = ap->in[3] + (size_t)1 * 128 * 128 * 128; L.cache_v = ap->in[4] + (size_t)1 * 128 * 128 * 128;
            L.Win_t = nullptr; L.Wp_t = nullptr; L.Wout_t = nullptr; L.PWT = (const bf16_t*)(ws + WS_PWT) + (size_t)1 * 4 * 64 * 64;
            for (int ui = bid; ui < 640; ui += G) {
#ifndef NO_ATT
                if (ui < 256) { const int kvh = ui & 1, bn = ui >> 1; att_unit(lds, bn >> 4, bn & 15, kvh, H1, XG, L.sinks, out + O_KP + (size_t)1 * 8 * 128 * 128, out + O_VP + (size_t)1 * 8 * 128 * 128); }
                else
#endif
#ifndef NO_SGU
                if (ui < 384) { if (ui >= 256) { const int bn = ui - 256; sgu_unit(lds, bn >> 4, bn & 15, H1, XG, L); } }
                else
#endif
#ifndef NO_POOL
                if (ui < 512) { if (ui >= 384) { const int bn = ui - 384; pool_unit(lds, bn >> 4, bn & 15, H1, XG, L, out + O_POOLP + (size_t)1 * 8 * 15 * 256); } }
                else
#endif
#ifndef NO_SAMPLE
                if (ui >= 512) { const int bs = ui - 512; sample_unit(lds, bs, H1, XG, L, out + O_POOLS + (size_t)1 * 128 * 15 * 256, out + O_KS + (size_t)1 * 128 * 128 * 128, out + O_VS + (size_t)1 * 128 * 128 * 128, out + O_CVS + (size_t)1 * 128 * 256); }
#endif
                {}
            }
        }
        GRID_BAR();
#ifndef NO_P3
        {
            KArgsP ap = kargs(); unsigned char* ws = ap->ws;
            pg8::Gemm g{(const bf16_t*)ap->out, (const bf16_t*)(ws + WS_WP) + (size_t)1 * DM * DM, MPAD, DM, DM}; pg8::StaticOrder S; S.init(MPAD, DM, G, bid);
            pg8::EpiMerge E{(bf16_t*)(ws + WS_H1), (const bf16_t*)(ws + WS_GT)};
            pg8::gemm_phase<pg8::EpiMerge, pg8::StaticOrder, true, true>(lds, g, S, E);
        }
#endif
        GRID_BAR();
#ifndef NO_P4
        {
            KArgsP ap = kargs(); unsigned char* ws = ap->ws;
            pg8::Gemm g{(const bf16_t*)(ws + WS_H1), (const bf16_t*)(ws + WS_WOUT) + (size_t)1 * DM * DM, MPAD, DM, DM}; pg8::StaticOrder S; S.init(MPAD, DM, G, bid);
            pg8::EpiOut E{(float*)(ws + WS_GT), ap->in[0], ap->in[1], (const bf16_t*)(ws + WS_X1), 1};
            pg8::gemm_phase<pg8::EpiOut, pg8::StaticOrder, true, true>(lds, g, S, E);
        }
#endif
        GRID_BAR();
        {
            KArgsP ap = kargs(); unsigned char* ws = ap->ws;
            ln_rows((const float*)(ws + WS_GT), ap->in[18] + (size_t)1 * DM, ap->in[19] + (size_t)1 * DM, (bf16_t*)(ws + WS_X1), ap->out, 1, bid, ngw);
        }
        if (1 + 1 < DEPTH) GRID_BAR();
    }
#undef GRID_BAR
    if (kargs()->use_cg != 0) { cg::this_grid().sync(); }
}

extern "C" void kernel_launch(void* const* d_in, const int* in_sizes, int n_in, void* d_out, int out_size, void* d_ws, size_t ws_size, hipStream_t stream) {
    static int grid = 0;
    if (grid == 0) {
        if (n_in != 20 || ws_size < WS_END) { fprintf(stderr, "kernel_launch: unexpected n_in %d / ws %zu\n", n_in, ws_size); grid = -1; return; }
        int dev = 0, cus = 0, per_cu = 0;
        if (hipGetDevice(&dev) != hipSuccess || hipDeviceGetAttribute(&cus, hipDeviceAttributeMultiprocessorCount, dev) != hipSuccess) { grid = -1; return; }
        if (hipOccupancyMaxActiveBlocksPerMultiprocessor(&per_cu, (const void*)mk_fwd, NTHR, 0) != hipSuccess || per_cu < 1) { fprintf(stderr, "kernel_launch: occupancy query says %d\n", per_cu); (void)hipGetLastError(); grid = -1; return; }
        grid = cus;
        if (grid > cus * per_cu) grid = cus * per_cu;
    }
    if (grid < 0) return;
    (void)hipMemsetAsync((char*)d_ws + WS_CTL, 0, CTL_ZERO_BYTES, stream);
    Args a{};
    for (int i = 0; i < 20; ++i) a.in[i] = (const float*)d_in[i];
    a.out = (float*)d_out; a.ws = (unsigned char*)d_ws;
    for (int i = 0; i < 32; ++i) a.inv[i] = (float)pow(10000.0, -(double)i / 32.0);
    a.use_cg = 0; a.pad = 0;
    void* kargs[] = {&a};
    hipError_t e = hipLaunchCooperativeKernel((const void*)mk_fwd, dim3(grid), dim3(NTHR), kargs, 0, stream);
    if (e != hipSuccess) fprintf(stderr, "cooperative launch failed: %s (grid %d)\n", hipGetErrorString(e), grid);
}
```

```cpp
#ifndef REP_P0
#define REP_P0 1
#endif
#ifndef REP_P1
#define REP_P1 1
#endif
#ifndef REP_P2
#define REP_P2 1
#endif
#ifndef REP_P3
#define REP_P3 1
#endif
#ifndef REP_P4
#define REP_P4 1
#endif
#ifndef REP_P5
#define REP_P5 1
#endif
#include <hip/hip_runtime.h>
#include <hip/hip_cooperative_groups.h>
#include <cstdio>
#include <cstdint>
namespace cg = cooperative_groups;

#define LAS __attribute__((address_space(3)))
#define GAS __attribute__((address_space(1)))
typedef unsigned short bf16_t;
typedef short bf16x8 __attribute__((ext_vector_type(8)));
typedef float f32x4 __attribute__((ext_vector_type(4)));
typedef float f32x2 __attribute__((ext_vector_type(2)));
typedef float f32x16 __attribute__((ext_vector_type(16)));
typedef unsigned u32x4 __attribute__((ext_vector_type(4)));
typedef unsigned u32x2 __attribute__((ext_vector_type(2)));

constexpr int DM = 1024, NB = 8, SEQ = 2048, DEPTH = 2, DB = 128;
constexpr int MP = NB * SEQ;
constexpr int MS = DB;
constexpr int MREAL = MP + MS;
constexpr int MPAD = 16640;
constexpr int DIN = 5632, H1W = 2560, GW = 3072;
constexpr int C_XA = 0, C_ZA = 256, C_U = 512, C_V = 768, C_ZB = 1024, C_Q = 1280, C_K = 1792, C_VV = 1920, C_ZC = 2048;
constexpr float ALPHA = 1.4142135623730951f;
constexpr float LN_EPS = 1e-5f;
constexpr float LOG2E = 1.4426950408889634f;
constexpr size_t O_YP = 0, O_YS = 16777216, O_POOLP = 16908288, O_KP = 16969728, O_VP = 17231872, O_POOLS = 17494016,
                 O_KS = 18477056, O_VS = 22671360, O_CVS = 26865664;
constexpr size_t MiB = 1u << 20;
constexpr size_t WS_CTL = 0, CTL_ZERO_BYTES = 65536;
constexpr size_t WS_ROPE = 1 * MiB;
constexpr size_t WS_PWT = 2 * MiB;
constexpr size_t WS_WIN = 4 * MiB;
constexpr size_t WS_WP = 26 * MiB;
constexpr size_t WS_WOUT = 30 * MiB;
constexpr size_t WS_X1 = 34 * MiB;
constexpr size_t WS_H1 = 67 * MiB;
constexpr size_t WS_GT = 149 * MiB;
constexpr size_t WS_END = 247 * MiB;
constexpr int ROPE_N = 2049 * 32;

typedef __bf16 bf16x2_t __attribute__((ext_vector_type(2)));
__device__ __forceinline__ unsigned cvt_pk_bf16(float lo, float hi) { f32x2 v = {lo, hi}; bf16x2_t b = __builtin_convertvector(v, bf16x2_t); return __builtin_bit_cast(unsigned, b); }
__device__ __forceinline__ float bf_lo(unsigned w) { return __uint_as_float(w << 16); }
__device__ __forceinline__ float bf_hi(unsigned w) { return __uint_as_float(w & 0xffff0000u); }
__device__ __forceinline__ float bf2f(bf16_t b) { return __uint_as_float((unsigned)b << 16); }
__device__ __forceinline__ float sigmoidf_(float v) { return __builtin_amdgcn_rcpf(1.0f + __builtin_amdgcn_exp2f(-v * LOG2E)); }
__device__ __forceinline__ float siluf_(float v) { return v * sigmoidf_(v); }
__device__ __forceinline__ int opaque_tid() { int t = threadIdx.x; asm volatile("" : "+v"(t)); return t; }
__device__ __forceinline__ float wave_sum(float v) {
#pragma unroll
    for (int o = 1; o < 64; o <<= 1) v += __shfl_xor(v, o);
    return v;
}
__device__ __forceinline__ float wave_max(float v) {
#pragma unroll
    for (int o = 1; o < 64; o <<= 1) v = fmaxf(v, __shfl_xor(v, o));
    return v;
}

namespace pg8 {
#define PG8_LAS __attribute__((address_space(3)))
constexpr int BM = 256, BK = 64, HALF = 128, HTB = HALF * BK * 2, STAGE_BYTES = 8 * HTB, NXCD = 8, WGM = 8;
__host__ __device__ __forceinline__ int lds_byte(int r, int c) { const int st = (r >> 4) * 2 + (c >> 5), rr = r & 15, cc = c & 31, ob = rr * 64 + cc * 2; return st * 1024 + (ob ^ (((ob >> 9) & 1) << 5)); }
__host__ __device__ __forceinline__ void stage_rc(int b, int& R, int& C) { const int st = b / 1024, sb = b % 1024, swz = sb ^ (((sb >> 9) & 1) << 5); R = (st >> 1) * 16 + swz / 64; C = (st & 1) * 32 + (swz % 64) / 2; }
__host__ __device__ __forceinline__ int perm32(int rho) { const int n = rho >> 4, i = rho & 15; return 8 * (i >> 2) + 4 * n + (i & 3); }

struct Unit { int pm, pn; };
struct Gemm { const bf16_t* A; const bf16_t* Bt; int M, N, K; };

struct StaticOrder {
    int nM, nN, nwg, G, c;
    __host__ __device__ void init(int M, int N, int G_, int c_) { nM = M / BM; nN = N / BM; nwg = nM * nN; G = G_; c = c_; }
    __host__ __device__ bool next(int i, Unit& u) const {
        const long L = (long)i * G + c; if (L >= nwg) return false;
        int wgid = (int)L; { const int q = nwg / NXCD, r = nwg % NXCD, xcd = wgid % NXCD, off = wgid / NXCD; wgid = (xcd < r ? xcd * (q + 1) : r * (q + 1) + (xcd - r) * q) + off; }
        const int nig = WGM * nN, gid = wgid / nig, fm = gid * WGM, gsz = (nM - fm) < WGM ? (nM - fm) : WGM;
        u.pm = fm + ((wgid % nig) % gsz); u.pn = (wgid % nig) / gsz; return true;
    }
    __device__ __forceinline__ void a_ready(const Unit&) const {}
    __device__ __forceinline__ void done(const Unit&) const {}
};


struct EpiInProj {
    static constexpr bool PERM = true, AFTER_DRAIN = false, HAS_MID = false;
    bf16_t* H1; bf16_t* GT; const float* bgate; const float* ropec; const float* ropes;
    __device__ __forceinline__ void mid(f32x4 (&)[2][2][4][2], const Unit&, int, int, int, int, int) const {}
    __device__ __forceinline__ void operator()(const f32x4 (&acc)[2][2][4][2], const Unit& u, int wr, int wc, int fr, int fq) const {
        int row0 = u.pm * BM + wr * 64 + fr;
        asm volatile("" : "+v"(row0));
        if (u.pn >= 10) {
            const int colg = (u.pn - 10) * BM + wc * 32 + 8 * fq;
            f32x4 bv[2][2];
#pragma unroll
            for (int bj = 0; bj < 2; ++bj)
#pragma unroll
                for (int n = 0; n < 2; ++n) bv[bj][n] = *(const f32x4*)(bgate + colg + bj * HALF + 4 * n);
#pragma unroll
            for (int ai = 0; ai < 2; ++ai)
#pragma unroll
                for (int m = 0; m < 4; ++m) { bf16_t* rowp = GT + (size_t)(row0 + ai * HALF + m * 16) * GW + colg;
#pragma unroll
                    for (int bj = 0; bj < 2; ++bj) { const f32x4 v0 = acc[ai][bj][m][0] + bv[bj][0], v1 = acc[ai][bj][m][1] + bv[bj][1];
                        u32x4 w; w.x = cvt_pk_bf16(sigmoidf_(v0[0]), sigmoidf_(v0[1])); w.y = cvt_pk_bf16(sigmoidf_(v0[2]), sigmoidf_(v0[3]));
                        w.z = cvt_pk_bf16(sigmoidf_(v1[0]), sigmoidf_(v1[1])); w.w = cvt_pk_bf16(sigmoidf_(v1[2]), sigmoidf_(v1[3]));
                        *(u32x4*)(rowp + bj * HALF) = w; } }
        } else {
            const int colt = u.pn * BM;
            const bool anyrope = (u.pn >= 5 && u.pn <= 7);
            const int d0 = 16 * (wc & 1) + 4 * fq;
#pragma unroll
            for (int ai = 0; ai < 2; ++ai)
#pragma unroll
                for (int m = 0; m < 4; ++m) { const int row = row0 + ai * HALF + m * 16; bf16_t* rowp = H1 + (size_t)row * H1W + colt;
                    f32x4 c4 = (f32x4){1.f, 1.f, 1.f, 1.f}, s4 = (f32x4){0.f, 0.f, 0.f, 0.f};
                    if (anyrope) { const int pidx = row < MP ? (row & (SEQ - 1)) : 2048; c4 = *(const f32x4*)(ropec + pidx * 32 + d0); s4 = *(const f32x4*)(ropes + pidx * 32 + d0); }
#pragma unroll
                    for (int bj = 0; bj < 2; ++bj) {
                        const bool rp = (u.pn == 5 || u.pn == 6 || (u.pn == 7 && bj == 0));
                        const f32x4 x1 = acc[ai][bj][m][0], x2 = acc[ai][bj][m][1];
                        if (rp) {
                            const f32x4 y1 = x1 * c4 - x2 * s4, y2 = x2 * c4 + x1 * s4;
                            bf16_t* hp = rowp + bj * HALF + 64 * (wc >> 1) + d0;
                            u32x2 a; a.x = cvt_pk_bf16(y1[0], y1[1]); a.y = cvt_pk_bf16(y1[2], y1[3]);
                            u32x2 b; b.x = cvt_pk_bf16(y2[0], y2[1]); b.y = cvt_pk_bf16(y2[2], y2[3]);
                            *(u32x2*)hp = a; *(u32x2*)(hp + 32) = b;
                        } else {
                            u32x4 w; w.x = cvt_pk_bf16(x1[0], x1[1]); w.y = cvt_pk_bf16(x1[2], x1[3]); w.z = cvt_pk_bf16(x2[0], x2[1]); w.w = cvt_pk_bf16(x2[2], x2[3]);
                            *(u32x4*)(rowp + bj * HALF + wc * 32 + 8 * fq) = w;
                        }
                    }
                    asm volatile("" ::: "memory"); }
        }
    }
};

struct EpiMerge {
    static constexpr bool PERM = true, AFTER_DRAIN = false, HAS_MID = true;
    bf16_t* O; const bf16_t* GT;
    __device__ __forceinline__ void mid(f32x4 (&acc)[2][2][4][2], const Unit& u, int wr, int wc, int fr, int fq, int which) const {
        int row0 = u.pm * BM + wr * 64 + fr, col0 = u.pn * BM + wc * 32 + 8 * fq;
        asm volatile("" : "+v"(row0), "+v"(col0));
#pragma unroll
        for (int ai = 0; ai < 2; ++ai)
#pragma unroll
            for (int m = 0; m < 4; ++m) { const bf16_t* gp = GT + (size_t)(row0 + ai * HALF + m * 16) * GW + which * DM + col0;
#pragma unroll
                for (int bj = 0; bj < 2; ++bj) { const u32x4 ga = *(const u32x4*)(gp + bj * HALF), gb = *(const u32x4*)(gp + DM + bj * HALF);
                    f32x4 r0, r1;
                    r0[0] = bf_lo(ga.x) * __builtin_amdgcn_rcpf(fmaxf(bf_lo(gb.x), 1e-30f)); r0[1] = bf_hi(ga.x) * __builtin_amdgcn_rcpf(fmaxf(bf_hi(gb.x), 1e-30f));
                    r0[2] = bf_lo(ga.y) * __builtin_amdgcn_rcpf(fmaxf(bf_lo(gb.y), 1e-30f)); r0[3] = bf_hi(ga.y) * __builtin_amdgcn_rcpf(fmaxf(bf_hi(gb.y), 1e-30f));
                    r1[0] = bf_lo(ga.z) * __builtin_amdgcn_rcpf(fmaxf(bf_lo(gb.z), 1e-30f)); r1[1] = bf_hi(ga.z) * __builtin_amdgcn_rcpf(fmaxf(bf_hi(gb.z), 1e-30f));
                    r1[2] = bf_lo(ga.w) * __builtin_amdgcn_rcpf(fmaxf(bf_lo(gb.w), 1e-30f)); r1[3] = bf_hi(ga.w) * __builtin_amdgcn_rcpf(fmaxf(bf_hi(gb.w), 1e-30f));
                    acc[ai][bj][m][0] *= r0; acc[ai][bj][m][1] *= r1; }
                asm volatile("" ::: "memory"); }
    }
    __device__ __forceinline__ void operator()(const f32x4 (&acc)[2][2][4][2], const Unit& u, int wr, int wc, int fr, int fq) const {
        int row0 = u.pm * BM + wr * 64 + fr, col0 = u.pn * BM + wc * 32 + 8 * fq;
        asm volatile("" : "+v"(row0), "+v"(col0));
#pragma unroll
        for (int ai = 0; ai < 2; ++ai)
#pragma unroll
            for (int m = 0; m < 4; ++m) { const size_t row = (size_t)(row0 + ai * HALF + m * 16); const bf16_t* gp = GT + row * GW + 2 * DM + col0; bf16_t* op = O + row * DM + col0;
#pragma unroll
                for (int bj = 0; bj < 2; ++bj) { const u32x4 g = *(const u32x4*)(gp + bj * HALF); const f32x4 v0 = acc[ai][bj][m][0], v1 = acc[ai][bj][m][1];
                    u32x4 w; w.x = cvt_pk_bf16(v0[0] * bf_lo(g.x), v0[1] * bf_hi(g.x)); w.y = cvt_pk_bf16(v0[2] * bf_lo(g.y), v0[3] * bf_hi(g.y));
                    w.z = cvt_pk_bf16(v1[0] * bf_lo(g.z), v1[1] * bf_hi(g.z)); w.w = cvt_pk_bf16(v1[2] * bf_lo(g.w), v1[3] * bf_hi(g.w));
                    *(u32x4*)(op + bj * HALF) = w; }
                asm volatile("" ::: "memory"); }
    }
};

struct EpiOut {
    static constexpr bool PERM = false, AFTER_DRAIN = false, HAS_MID = false;
    float* T; const float* xp; const float* xs; const bf16_t* X1; int layer;
    __device__ __forceinline__ void mid(f32x4 (&)[2][2][4][2], const Unit&, int, int, int, int, int) const {}
    __device__ __forceinline__ void operator()(const f32x4 (&acc)[2][2][4][2], const Unit& u, int wr, int wc, int fr, int fq) const {
        int row0 = u.pm * BM + wr * 64 + fr, col0 = u.pn * BM + wc * 32 + 4 * fq;
        asm volatile("" : "+v"(row0), "+v"(col0));
#pragma unroll
        for (int ai = 0; ai < 2; ++ai)
#pragma unroll
            for (int m = 0; m < 4; ++m) { const int row = row0 + ai * HALF + m * 16; float* tp = T + (size_t)row * DM + col0;
#pragma unroll
                for (int bj = 0; bj < 2; ++bj)
#pragma unroll
                    for (int n = 0; n < 2; ++n) { const int co = bj * HALF + n * 16; f32x4 x = (f32x4){0.f, 0.f, 0.f, 0.f};
                        if (layer == 0) { if (row < MP) x = *(const f32x4*)(xp + (size_t)row * DM + col0 + co); else if (row < MREAL) x = *(const f32x4*)(xs + (size_t)(row - MP) * DM + col0 + co); }
                        else { const u32x2 w = *(const u32x2*)(X1 + (size_t)row * DM + col0 + co); x = (f32x4){bf_lo(w.x), bf_hi(w.x), bf_lo(w.y), bf_hi(w.y)}; }
                        *(f32x4*)(tp + co) = x * ALPHA + acc[ai][bj][m][n]; } }
    }
};

template <class Epi, class Sched, bool ALIGN_EPI = false, bool SP2 = false>
__device__ __forceinline__ void gemm_phase(PG8_LAS unsigned char* lds, const Gemm g, const Sched& S, const Epi& E) {
    const int tid = opaque_tid(), wid = __builtin_amdgcn_readfirstlane(tid >> 6), lane = tid & 63, wr = wid >> 2, wc = wid & 3, fr = lane & 15, fq = lane >> 4;
    const int K = g.K, nt = K / BK;
    unsigned voffA, voffB;
    { int R, C; stage_rc(tid * 16, R, C); const int Rb = Epi::PERM ? ((R & ~31) + perm32(R & 31)) : R;
        voffA = (unsigned)(R * K + C) * 2u; voffB = (unsigned)(Rb * K + C) * 2u; }
    const size_t pstep = (size_t)64 * K * 2;
    const size_t kstep = (size_t)(BK * 2);
    const size_t hstep = (size_t)HALF * K * 2;
    const size_t tstep = 2 * hstep;
    const unsigned ldsw = (unsigned)wid * 1024u;
    const int aoff = lds_byte(wr * 64 + fr, fq * 8); int boffB = lds_byte(wc * 32 + fr, fq * 8) + 4 * HTB;
    asm volatile("" : "+v"(boffB));
#define PG8_SA(b, h) (((b) * 2 + (h)) * HTB)
#define PG8_SB(b, h) ((4 + (b) * 2 + (h)) * HTB)
#define PG8_SBR(b, h) (((b) * 2 + (h)) * HTB)
#define PG8_STAGE(bufoff, gbase, voff) do { _Pragma("unroll") for (int _i = 0; _i < 2; ++_i) \
        __builtin_amdgcn_global_load_lds((const unsigned*)((const char*)(gbase) + _i * pstep + (voff)), (PG8_LAS unsigned*)(lds + (bufoff) + ldsw + _i * 8192), 16, 0, 0); } while (0)
#define PG8_LDA(dst, b, h) do { _Pragma("unroll") for (int m = 0; m < 4; ++m) _Pragma("unroll") for (int k = 0; k < 2; ++k) dst[m][k] = *(const PG8_LAS bf16x8*)(lds + PG8_SA(b, h) + aoff + m * 2048 + k * 1024); } while (0)
#define PG8_LDB(dst, b, h) do { _Pragma("unroll") for (int n = 0; n < 2; ++n) _Pragma("unroll") for (int k = 0; k < 2; ++k) dst[n][k] = *(const PG8_LAS bf16x8*)(lds + boffB + (PG8_SBR(b, h) + n * 2048 + k * 1024)); } while (0)
#define PG8_MMA(ai, bj, At, Bt) do { __builtin_amdgcn_s_setprio(1); _Pragma("unroll") for (int m = 0; m < 4; ++m) _Pragma("unroll") for (int n = 0; n < 2; ++n) _Pragma("unroll") for (int k = 0; k < 2; ++k) \
        acc[ai][bj][m][n] = __builtin_amdgcn_mfma_f32_16x16x32_bf16(Bt[n][k], At[m][k], acc[ai][bj][m][n], 0, 0, 0); __builtin_amdgcn_s_setprio(0); } while (0)
#define PG8_WAIT_V(n) asm volatile("s_waitcnt vmcnt(" #n ")" ::: "memory")
#define PG8_WAIT_L(n) asm volatile("s_waitcnt lgkmcnt(" #n ")" ::: "memory")
#define PG8_BAR __builtin_amdgcn_s_barrier()
#define PG8_SCHED __builtin_amdgcn_sched_barrier(0)
#define PG8_KBODY() do { \
            const bool last = (t == nt - 2); \
            const char* a1 = cA + (size_t)(t + 1) * kstep; \
            const char* a2 = last ? nA : cA + (size_t)(t + 2) * kstep; const char* b2 = last ? nB : cB + (size_t)(t + 2) * kstep; \
            const char* a3 = a2 + kstep; const char* b3 = b2 + kstep; \
            if (last && has_next) S.a_ready(nxt); \
            if constexpr (SP2) { \
            PG8_LDB(B0, 0, 0); PG8_LDB(B1, 0, 1); PG8_SCHED; PG8_LDA(At, 0, 0); PG8_STAGE(PG8_SA(1, 1), a1 + hstep, voffA); \
            PG8_WAIT_V(8); PG8_WAIT_L(0); PG8_BAR; PG8_MMA(0, 0, At, B0); PG8_MMA(0, 1, At, B1); PG8_BAR; PG8_SCHED; \
            PG8_LDA(At, 0, 1); PG8_STAGE(PG8_SB(0, 0), b2, voffB); PG8_STAGE(PG8_SB(0, 1), b2 + hstep, voffB); PG8_STAGE(PG8_SA(0, 0), a2, voffA); \
            PG8_WAIT_V(8); PG8_WAIT_L(0); PG8_BAR; PG8_MMA(1, 0, At, B0); PG8_MMA(1, 1, At, B1); PG8_BAR; PG8_SCHED; \
            PG8_LDB(B0, 1, 0); PG8_LDB(B1, 1, 1); PG8_SCHED; PG8_LDA(At, 1, 0); PG8_STAGE(PG8_SA(0, 1), a2 + hstep, voffA); \
            PG8_WAIT_V(8); PG8_WAIT_L(0); PG8_BAR; PG8_MMA(0, 0, At, B0); PG8_MMA(0, 1, At, B1); PG8_BAR; PG8_SCHED; \
            PG8_LDA(At, 1, 1); PG8_STAGE(PG8_SB(1, 0), b3, voffB); PG8_STAGE(PG8_SB(1, 1), b3 + hstep, voffB); PG8_STAGE(PG8_SA(1, 0), a3, voffA); \
            PG8_WAIT_V(8); PG8_WAIT_L(0); PG8_BAR; PG8_MMA(1, 0, At, B0); PG8_MMA(1, 1, At, B1); PG8_BAR; PG8_SCHED; \
            } else { \
            PG8_LDB(B0, 0, 0); PG8_SCHED; PG8_LDA(At, 0, 0); PG8_STAGE(PG8_SA(1, 1), a1 + hstep, voffA); \
            PG8_WAIT_L(8); PG8_BAR; PG8_WAIT_L(0); PG8_MMA(0, 0, At, B0); PG8_BAR; PG8_SCHED; \
            PG8_LDB(B1, 0, 1); PG8_STAGE(PG8_SB(0, 0), b2, voffB); \
            PG8_BAR; PG8_WAIT_L(0); PG8_MMA(0, 1, At, B1); PG8_BAR; \
            PG8_LDA(At, 0, 1); PG8_STAGE(PG8_SA(0, 0), a2, voffA); \
            PG8_BAR; PG8_WAIT_L(0); PG8_MMA(1, 0, At, B0); PG8_BAR; PG8_SCHED; \
            PG8_STAGE(PG8_SB(0, 1), b2 + hstep, voffB); \
            PG8_WAIT_V(6); PG8_BAR; PG8_MMA(1, 1, At, B1); PG8_BAR; \
            PG8_LDB(B0, 1, 0); PG8_SCHED; PG8_LDA(At, 1, 0); PG8_STAGE(PG8_SA(0, 1), a2 + hstep, voffA); \
            PG8_WAIT_L(8); PG8_BAR; PG8_WAIT_L(0); PG8_MMA(0, 0, At, B0); PG8_BAR; PG8_SCHED; \
            PG8_LDB(B1, 1, 1); PG8_STAGE(PG8_SB(1, 0), b3, voffB); \
            PG8_BAR; PG8_WAIT_L(0); PG8_MMA(0, 1, At, B1); PG8_BAR; \
            PG8_LDA(At, 1, 1); PG8_STAGE(PG8_SA(1, 0), a3, voffA); \
            PG8_BAR; PG8_WAIT_L(0); PG8_MMA(1, 0, At, B0); PG8_BAR; PG8_SCHED; \
            PG8_STAGE(PG8_SB(1, 1), b3 + hstep, voffB); \
            PG8_WAIT_V(6); PG8_BAR; PG8_MMA(1, 1, At, B1); PG8_BAR; \
            } \
        } while (0)
    Unit cur, nxt; int ui = 0;
    if (!S.next(0, cur)) return;
    f32x4 acc[2][2][4][2];
#pragma unroll
    for (int a = 0; a < 2; ++a)
#pragma unroll
        for (int b = 0; b < 2; ++b)
#pragma unroll
            for (int m = 0; m < 4; ++m)
#pragma unroll
                for (int n = 0; n < 2; ++n) acc[a][b][m][n] = (f32x4){0.f, 0.f, 0.f, 0.f};
    bf16x8 At[4][2], B0[2][2], B1[2][2];
    const char* cA = (const char*)g.A + (size_t)cur.pm * tstep; const char* cB = (const char*)g.Bt + (size_t)cur.pn * tstep;
    S.a_ready(cur);
    if constexpr (SP2) {
        PG8_STAGE(PG8_SB(0, 0), cB, voffB); PG8_STAGE(PG8_SB(0, 1), cB + hstep, voffB); PG8_STAGE(PG8_SA(0, 0), cA, voffA); PG8_STAGE(PG8_SA(0, 1), cA + hstep, voffA);
        if (wr == 1) PG8_BAR;
        PG8_WAIT_V(2); PG8_BAR;
        PG8_STAGE(PG8_SB(1, 0), cB + kstep, voffB); PG8_STAGE(PG8_SA(1, 0), cA + kstep, voffA); PG8_STAGE(PG8_SB(1, 1), cB + hstep + kstep, voffB);
        PG8_WAIT_V(6); PG8_BAR;
    } else {
        PG8_STAGE(PG8_SB(0, 0), cB, voffB); PG8_STAGE(PG8_SA(0, 0), cA, voffA); PG8_STAGE(PG8_SB(0, 1), cB + hstep, voffB); PG8_STAGE(PG8_SA(0, 1), cA + hstep, voffA);
        if (wr == 1) PG8_BAR;
        PG8_WAIT_V(4); PG8_BAR;
        PG8_STAGE(PG8_SB(1, 0), cB + kstep, voffB); PG8_STAGE(PG8_SA(1, 0), cA + kstep, voffA); PG8_STAGE(PG8_SB(1, 1), cB + hstep + kstep, voffB);
        PG8_WAIT_V(6); PG8_BAR;
    }
    for (;;) {
        const bool has_next = S.next(ui + 1, nxt);
        const char* nA = has_next ? (const char*)g.A + (size_t)nxt.pm * tstep : cA; const char* nB = has_next ? (const char*)g.Bt + (size_t)nxt.pn * tstep : cB;
        if constexpr (Epi::HAS_MID) {
            for (int t = 0; t < 4; t += 2) PG8_KBODY();
            E.mid(acc, cur, wr, wc, fr, fq, 0);
            for (int t = 4; t < 8; t += 2) PG8_KBODY();
            E.mid(acc, cur, wr, wc, fr, fq, 1);
            for (int t = 8; t < nt; t += 2) PG8_KBODY();
        } else {
            for (int t = 0; t < nt; t += 2) PG8_KBODY();
        }
        if constexpr (ALIGN_EPI) { if (wr == 0) PG8_BAR; }
        if constexpr (!Epi::AFTER_DRAIN) { E(acc, cur, wr, wc, fr, fq); S.done(cur); }
        if (!has_next) break;
#pragma unroll
        for (int a = 0; a < 2; ++a)
#pragma unroll
            for (int b = 0; b < 2; ++b)
#pragma unroll
                for (int m = 0; m < 4; ++m)
#pragma unroll
                    for (int n = 0; n < 2; ++n) acc[a][b][m][n] = (f32x4){0.f, 0.f, 0.f, 0.f};
        cur = nxt; cA = nA; cB = nB; ++ui;
        if constexpr (ALIGN_EPI) { if (wr == 1) PG8_BAR; }
    }
    PG8_WAIT_V(0);
    if constexpr (!ALIGN_EPI) { if (wr == 0) PG8_BAR; }
    PG8_BAR;
#undef PG8_SA
#undef PG8_SB
#undef PG8_SBR
#undef PG8_STAGE
#undef PG8_LDA
#undef PG8_LDB
#undef PG8_MMA
#undef PG8_WAIT_V
#undef PG8_WAIT_L
#undef PG8_BAR
#undef PG8_SCHED
#undef PG8_KBODY
}
}

#define XB_TMO      128
#define XB_XCNT(j)  (256  + 64 * (j))
#define XB_XSUB(j)  (1280 + 64 * (j))
#define XB_XGEN(j)  (2304 + 64 * (j))
#define XB_TOP      3328
#define XB_TOPGEN   3392
#define XCD_BAR_WORDS 3456
#define XB_SPIN_CAP (1u << 18)
__device__ __forceinline__ unsigned xb_ld(unsigned* p)              { return __hip_atomic_load(p, __ATOMIC_RELAXED, __HIP_MEMORY_SCOPE_AGENT); }
__device__ __forceinline__ unsigned xb_add(unsigned* p, unsigned v) { return __hip_atomic_fetch_add(p, v, __ATOMIC_RELAXED, __HIP_MEMORY_SCOPE_AGENT); }
__device__ __forceinline__ unsigned xb_xcc_id() { return (unsigned)__builtin_amdgcn_s_getreg((3 << 11) | 20) & 0xFu; }
#define XB_SPIN(cond, bar) do { unsigned _sp = 0; while (cond) { __builtin_amdgcn_s_sleep(1); \
    if ((++_sp & 255u) == 0u) { if (xb_ld(&(bar)[XB_TMO])) break; if (_sp > XB_SPIN_CAP) { atomicAdd(&(bar)[XB_TMO], 1u); break; } } } } while (0)
struct XcdBarrier { unsigned* bar; unsigned x; volatile LAS unsigned* st; };
__device__ __forceinline__ XcdBarrier xcd_barrier_post(unsigned* bar, volatile LAS unsigned* st) {
    XcdBarrier b; b.bar = bar; b.x = xb_xcc_id(); b.st = st;
    if (threadIdx.x == 0) (void)xb_add(&bar[XB_XCNT(b.x)], 1u);
    return b;
}
__device__ __forceinline__ void xcd_barrier_complete(unsigned* bar, unsigned x, unsigned& nloc, unsigned& nx) {
    const unsigned G = gridDim.x * gridDim.y * gridDim.z;
    unsigned sum, cnt, mine = 0u, sp = 0u;
    for (;;) {
        sum = 0u; cnt = 0u;
#pragma unroll 1
        for (unsigned j = 0; j < 16; ++j) { const unsigned c = xb_ld(&bar[XB_XCNT(j)]); sum += c; cnt += (c > 0u) ? 1u : 0u; }
        mine = xb_ld(&bar[XB_XCNT(x)]);
        if (sum == G) break;
        __builtin_amdgcn_s_sleep(1);
        if ((++sp & 255u) == 0u) { if (xb_ld(&bar[XB_TMO])) break; if (sp > XB_SPIN_CAP) { atomicAdd(&bar[XB_TMO], 1u); break; } }
    }
    nloc = mine > 0u ? mine : 1u; nx = cnt > 0u ? cnt : 1u;
}
__device__ __forceinline__ void xcd_barrier(const XcdBarrier& b) {
    asm volatile("s_waitcnt vmcnt(0)" ::: "memory");
    __syncthreads();
    if (threadIdx.x == 0) {
        unsigned* bar = b.bar;
        __builtin_amdgcn_s_waitcnt(0);
        unsigned nloc = b.st[0], nx = b.st[1];
        if (nloc == 0u) { xcd_barrier_complete(bar, b.x, nloc, nx); b.st[0] = nloc; b.st[1] = nx; }
        const unsigned old = xb_add(&bar[XB_XSUB(b.x)], 1u);
        const unsigned gen = old / nloc;
        if (old + 1u == (gen + 1u) * nloc) {
            __builtin_amdgcn_fence(__ATOMIC_RELEASE, "agent");
            asm volatile("s_waitcnt vmcnt(0)" ::: "memory");
            const unsigned og = xb_add(&bar[XB_TOP], 1u);
            const unsigned tg = og / nx;
            if (og + 1u == (tg + 1u) * nx) xb_add(&bar[XB_TOPGEN], 1u);
            else XB_SPIN(xb_ld(&bar[XB_TOPGEN]) == tg, bar);
            __builtin_amdgcn_fence(__ATOMIC_ACQUIRE, "agent");
            xb_add(&bar[XB_XGEN(b.x)], 1u);
            asm volatile("s_waitcnt vmcnt(0)" ::: "memory");
        } else {
            XB_SPIN(xb_ld(&bar[XB_XGEN(b.x)]) == gen, bar);
            __builtin_amdgcn_fence(__ATOMIC_ACQUIRE, "agent");
            asm volatile("s_waitcnt vmcnt(0)" ::: "memory");
        }
    }
    __syncthreads();
}

constexpr int NWAVES = 8, NTHR = 512;
constexpr int RING_BYTES = 131072, LDSCTL_OFF = RING_BYTES, LDS_BYTES = 147456;

struct Args { const float* in[20]; float* out; unsigned char* ws; float inv[32]; int use_cg; int pad; };

struct LayerW {
    const float *bgate, *pool_w, *pool_scale, *sgu_g, *sgu_b_ln, *sgu_w, *sgu_b, *sinks, *ln_g, *ln_b;
    const float *state_pool, *cache_k, *cache_v;
    const bf16_t *Win_t, *Wp_t, *Wout_t, *PWT;
};

__device__ __forceinline__ int win_rowmap(int ncol) {
    if (ncol < C_Q || ncol >= C_VV) return ncol;
    const int hb = ncol & ~63, d = ncol & 63, nn = d >> 5, r = d & 31;
    return hb + 32 * (r >> 4) + 8 * ((r >> 2) & 3) + 4 * nn + (r & 3);
}
template <bool MAP>
__device__ __forceinline__ void p0_transpose_item(const float* W, int N, bf16_t* WT, int ldt, int koff, LAS float* scr, int item, int lane) {
    const int nblk = N / 32, kb = item / nblk, nb = item % nblk, k0 = 64 * kb, n0 = 32 * nb;
#pragma unroll 8
    for (int i = 0; i < 32; ++i) { const int kk = 2 * i + (lane >> 5); scr[kk * 33 + (lane & 31)] = W[(size_t)(k0 + kk) * N + n0 + (lane & 31)]; }
    asm volatile("s_waitcnt lgkmcnt(0)" ::: "memory");
    const int c = lane & 7;
#pragma unroll
    for (int j = 0; j < 4; ++j) { const int n = (lane >> 3) + 8 * j; const LAS float* s = scr + (8 * c) * 33 + n;
        u32x4 o; o.x = cvt_pk_bf16(s[0 * 33], s[1 * 33]); o.y = cvt_pk_bf16(s[2 * 33], s[3 * 33]); o.z = cvt_pk_bf16(s[4 * 33], s[5 * 33]); o.w = cvt_pk_bf16(s[6 * 33], s[7 * 33]);
        const int nr = MAP ? win_rowmap(n0 + n) : (n0 + n);
        *(u32x4*)(WT + (size_t)nr * ldt + koff + k0 + 8 * c) = o; }
    asm volatile("s_waitcnt lgkmcnt(0)" ::: "memory");
}
__device__ __forceinline__ void sincos_acc(float ang, float& s, float& c) {
    const double a = (double)ang;
    const double kq = rint(a * 0.63661977236758134308);
    const double r = fma(-kq, 1.57079632679489661923, a) - kq * 6.123233995736766e-17;
    const double r2 = r * r;
    double sp = -7.647163731819816e-13; sp = sp * r2 + 1.605904383682161e-10; sp = sp * r2 - 2.505210838544172e-08; sp = sp * r2 + 2.755731922398589e-06;
    sp = sp * r2 - 1.984126984126984e-04; sp = sp * r2 + 8.333333333333333e-03; sp = sp * r2 - 1.666666666666667e-01; sp = r + r * r2 * sp;
    double cp = 4.779477332387385e-14; cp = cp * r2 - 1.147074559772972e-11; cp = cp * r2 + 2.087675698786810e-09; cp = cp * r2 - 2.755731922398589e-07;
    cp = cp * r2 + 2.480158730158730e-05; cp = cp * r2 - 1.388888888888889e-03; cp = cp * r2 + 4.166666666666666e-02; cp = cp * r2 - 0.5; cp = 1.0 + r2 * cp;
    const int q = ((int)kq) & 3;
    const double ss = (q == 0) ? sp : (q == 1) ? cp : (q == 2) ? -sp : -cp;
    const double cc = (q == 0) ? cp : (q == 1) ? -sp : (q == 2) ? -cp : sp;
    s = (float)ss; c = (float)cc;
}

constexpr int KL_STRIDE = 144, VT_STRIDE = 520, KL_BYTES = 256 * KL_STRIDE, VT_OFF = KL_BYTES;
__device__ __forceinline__ void att_unit(LAS unsigned char* sm, int b, int n, int kvh, const bf16_t* H1, bf16_t* G, const float* sinks, float* outK, float* outV) {
    const int tid = opaque_tid(), lane = tid & 63, wave = __builtin_amdgcn_readfirstlane(tid >> 6), r32 = lane & 31, hi = lane >> 5;
    const int m0 = b * SEQ + n * 128;
    for (int c = tid; c < 2048; c += NTHR) {
        const int key = c >> 3, ch = c & 7;
        u32x4 kv = (u32x4){0u, 0u, 0u, 0u}, vv = (u32x4){0u, 0u, 0u, 0u};
        if (!(n == 0 && key < 128)) {
            const bf16_t* rp = H1 + (size_t)(m0 - 128 + key) * H1W;
            kv = *(const u32x4*)(rp + C_K + kvh * 64 + ch * 8);
            vv = *(const u32x4*)(rp + C_VV + kvh * 64 + ch * 8);
        }
        *(LAS u32x4*)(sm + key * KL_STRIDE + ch * 16) = kv;
        LAS bf16_t* vt = (LAS bf16_t*)(sm + VT_OFF) + (ch * 8) * (VT_STRIDE / 2) + key;
        vt[0 * (VT_STRIDE / 2)] = (bf16_t)(vv.x & 0xffffu); vt[1 * (VT_STRIDE / 2)] = (bf16_t)(vv.x >> 16);
        vt[2 * (VT_STRIDE / 2)] = (bf16_t)(vv.y & 0xffffu); vt[3 * (VT_STRIDE / 2)] = (bf16_t)(vv.y >> 16);
        vt[4 * (VT_STRIDE / 2)] = (bf16_t)(vv.z & 0xffffu); vt[5 * (VT_STRIDE / 2)] = (bf16_t)(vv.z >> 16);
        vt[6 * (VT_STRIDE / 2)] = (bf16_t)(vv.w & 0xffffu); vt[7 * (VT_STRIDE / 2)] = (bf16_t)(vv.w >> 16);
        if (outK != nullptr && n == 15 && key >= 128) {
            const size_t o = ((size_t)(b * 128 + key - 128) * 2 + kvh) * 64 + ch * 8;
            *(f32x4*)(outK + o) = (f32x4){bf_lo(kv.x), bf_hi(kv.x), bf_lo(kv.y), bf_hi(kv.y)}; *(f32x4*)(outK + o + 4) = (f32x4){bf_lo(kv.z), bf_hi(kv.z), bf_lo(kv.w), bf_hi(kv.w)};
            *(f32x4*)(outV + o) = (f32x4){bf_lo(vv.x), bf_hi(vv.x), bf_lo(vv.y), bf_hi(vv.y)}; *(f32x4*)(outV + o + 4) = (f32x4){bf_lo(vv.z), bf_hi(vv.z), bf_lo(vv.w), bf_hi(vv.w)};
        }
    }
    __syncthreads();
    const int hd = wave >> 1, ph = wave & 1, head = kvh * 4 + hd;
    const float sinkl = sinks[head] * LOG2E;
    const float C2 = 0.125f * LOG2E;
#pragma unroll 1
    for (int qi = 0; qi < 2; ++qi) {
        const int qt = 2 * ph + qi, p0 = 32 * qt;
        const bf16_t* qrow = H1 + (size_t)(m0 + p0 + r32) * H1W;
        bf16x8 qf[4];
#pragma unroll
        for (int d0 = 0; d0 < 4; ++d0) qf[d0] = *(const bf16x8*)(qrow + C_Q + head * 64 + d0 * 16 + hi * 8);
        f32x16 s[5];
#pragma unroll
        for (int j = 0; j < 5; ++j) {
            const int kt = qt + j;
            f32x16 a = {};
            const LAS unsigned char* kb = sm + (32 * kt + r32) * KL_STRIDE + hi * 16;
#pragma unroll
            for (int d0 = 0; d0 < 4; ++d0) { const bf16x8 kf = *(const LAS bf16x8*)(kb + d0 * 32); a = __builtin_amdgcn_mfma_f32_32x32x16_bf16(kf, qf[d0], a, 0, 0, 0); }
            const bool dead = (n == 0) && (kt < 4);
#pragma unroll
            for (int r = 0; r < 16; ++r) {
                const int jj = (r & 3) + 8 * (r >> 2) + 4 * hi;
                bool ok = !dead;
                if (j == 0) ok = ok && (jj >= r32);
                if (j == 4) ok = ok && (jj <= r32);
                a[r] = ok ? a[r] * C2 : -INFINITY;
            }
            s[j] = a;
        }
        float mx = -INFINITY;
#pragma unroll
        for (int j = 0; j < 5; ++j)
#pragma unroll
            for (int r = 0; r < 16; ++r) mx = fmaxf(mx, s[j][r]);
        mx = fmaxf(mx, __shfl_xor(mx, 32));
        mx = fmaxf(mx, sinkl);
        float lsum = 0.f;
#pragma unroll
        for (int j = 0; j < 5; ++j)
#pragma unroll
            for (int r = 0; r < 16; ++r) { const float p = __builtin_amdgcn_exp2f(s[j][r] - mx); s[j][r] = p; lsum += p; }
        lsum += __shfl_xor(lsum, 32);
        lsum += __builtin_amdgcn_exp2f(sinkl - mx);
        const float inv = 1.0f / lsum;
        f32x16 o[2]; o[0] = f32x16{}; o[1] = f32x16{};
#pragma unroll
        for (int j = 0; j < 5; ++j) {
            const int kt = qt + j;
#pragma unroll
            for (int s2 = 0; s2 < 2; ++s2) {
                u32x4 pw; pw.x = cvt_pk_bf16(s[j][8 * s2 + 0], s[j][8 * s2 + 1]); pw.y = cvt_pk_bf16(s[j][8 * s2 + 2], s[j][8 * s2 + 3]);
                pw.z = cvt_pk_bf16(s[j][8 * s2 + 4], s[j][8 * s2 + 5]); pw.w = cvt_pk_bf16(s[j][8 * s2 + 6], s[j][8 * s2 + 7]);
                const bf16x8 pf = __builtin_bit_cast(bf16x8, pw);
#pragma unroll
                for (int mt = 0; mt < 2; ++mt) {
                    const LAS unsigned char* vp = sm + VT_OFF + (32 * mt + r32) * VT_STRIDE + (32 * kt + 16 * s2 + 4 * hi) * 2;
                    const u32x2 v0 = *(const LAS u32x2*)vp, v1 = *(const LAS u32x2*)(vp + 16);
                    u32x4 vw; vw.x = v0.x; vw.y = v0.y; vw.z = v1.x; vw.w = v1.y;
                    o[mt] = __builtin_amdgcn_mfma_f32_32x32x16_bf16(__builtin_bit_cast(bf16x8, vw), pf, o[mt], 0, 0, 0);
                }
            }
        }
        bf16_t* grow = G + (size_t)(m0 + p0 + r32) * DM + 512 + head * 64;
#pragma unroll
        for (int mt = 0; mt < 2; ++mt)
#pragma unroll
            for (int g4 = 0; g4 < 4; ++g4) {
                const int dd = 32 * mt + 8 * g4 + 4 * hi;
                const u32x2 z = *(const u32x2*)(qrow + C_ZC + head * 64 + dd);
                const float y0 = o[mt][4 * g4 + 0] * inv * siluf_(bf_lo(z.x)), y1 = o[mt][4 * g4 + 1] * inv * siluf_(bf_hi(z.x));
                const float y2 = o[mt][4 * g4 + 2] * inv * siluf_(bf_lo(z.y)), y3 = o[mt][4 * g4 + 3] * inv * siluf_(bf_hi(z.y));
                u32x2 w; w.x = cvt_pk_bf16(y0, y1); w.y = cvt_pk_bf16(y2, y3);
                *(u32x2*)(grow + dd) = w;
            }
    }
    __syncthreads();
}

constexpr int VNT_STRIDE = 272;
__device__ __forceinline__ void sgu_unit(LAS unsigned char* sm, int b, int n, const bf16_t* H1, bf16_t* G, const LayerW& L) {
    const int tid = opaque_tid(), lane = tid & 63, wave = __builtin_amdgcn_readfirstlane(tid >> 6), r32 = lane & 31, hi = lane >> 5;
    const int m0 = b * SEQ + n * 128;
    {
        const f32x4 g4 = *(const f32x4*)(L.sgu_g + 4 * lane), b4 = *(const f32x4*)(L.sgu_b_ln + 4 * lane);
#pragma unroll 4
        for (int i = 0; i < 16; ++i) {
            const int t = wave * 16 + i;
            const u32x2 w = *(const u32x2*)(H1 + (size_t)(m0 + t) * H1W + C_V + 4 * lane);
            f32x4 x = (f32x4){bf_lo(w.x), bf_hi(w.x), bf_lo(w.y), bf_hi(w.y)};
            const float mean = wave_sum((x[0] + x[1]) + (x[2] + x[3])) * (1.f / 256.f);
            x = x - mean;
            const float var = wave_sum((x[0] * x[0] + x[1] * x[1]) + (x[2] * x[2] + x[3] * x[3])) * (1.f / 256.f);
            const float rstd = 1.0f / sqrtf(var + LN_EPS);
            x = x * rstd * g4 + b4;
            const unsigned p01 = cvt_pk_bf16(x[0], x[1]), p23 = cvt_pk_bf16(x[2], x[3]);
            LAS bf16_t* vp = (LAS bf16_t*)(sm + (4 * lane) * VNT_STRIDE) + t;
            vp[0] = (bf16_t)(p01 & 0xffffu); vp[VNT_STRIDE / 2] = (bf16_t)(p01 >> 16); vp[2 * (VNT_STRIDE / 2)] = (bf16_t)(p23 & 0xffffu); vp[3 * (VNT_STRIDE / 2)] = (bf16_t)(p23 >> 16);
        }
    }
    __syncthreads();
    const int g = wave >> 1, th = wave & 1;
#pragma unroll 1
    for (int ti = 0; ti < 2; ++ti) {
        const int tt = (ti == 0) ? th : 3 - th;
        const int t = 32 * tt + r32;
        f32x16 acc[2]; acc[0] = f32x16{}; acc[1] = f32x16{};
        const float* wrow = L.sgu_w + ((size_t)g * 128 + t) * 128;
        const int nks = 2 * (tt + 1);
#pragma unroll 1
        for (int ks = 0; ks < nks; ++ks) {
            const int s0 = 16 * ks + 8 * hi;
            const f32x4 w0 = *(const f32x4*)(wrow + s0), w1 = *(const f32x4*)(wrow + s0 + 4);
            u32x4 bw;
            bw.x = cvt_pk_bf16((s0 + 0 <= t) ? w0[0] : 0.f, (s0 + 1 <= t) ? w0[1] : 0.f); bw.y = cvt_pk_bf16((s0 + 2 <= t) ? w0[2] : 0.f, (s0 + 3 <= t) ? w0[3] : 0.f);
            bw.z = cvt_pk_bf16((s0 + 4 <= t) ? w1[0] : 0.f, (s0 + 5 <= t) ? w1[1] : 0.f); bw.w = cvt_pk_bf16((s0 + 6 <= t) ? w1[2] : 0.f, (s0 + 7 <= t) ? w1[3] : 0.f);
            const bf16x8 bf = __builtin_bit_cast(bf16x8, bw);
#pragma unroll
            for (int ct = 0; ct < 2; ++ct) {
                const bf16x8 af = *(const LAS bf16x8*)(sm + (g * 64 + 32 * ct + r32) * VNT_STRIDE + s0 * 2);
                acc[ct] = __builtin_amdgcn_mfma_f32_32x32x16_bf16(af, bf, acc[ct], 0, 0, 0);
            }
        }
        const float sb = L.sgu_b[g * 128 + t];
        const bf16_t* hrow = H1 + (size_t)(m0 + t) * H1W;
        bf16_t* grow = G + (size_t)(m0 + t) * DM + 256 + g * 64;
#pragma unroll
        for (int ct = 0; ct < 2; ++ct)
#pragma unroll
            for (int g4 = 0; g4 < 4; ++g4) {
                const int c0 = 32 * ct + 8 * g4 + 4 * hi;
                const u32x2 uu = *(const u32x2*)(hrow + C_U + g * 64 + c0), zz = *(const u32x2*)(hrow + C_ZB + g * 64 + c0);
                const float y0 = bf_lo(uu.x) * (acc[ct][4 * g4 + 0] + sb) * siluf_(bf_lo(zz.x)), y1 = bf_hi(uu.x) * (acc[ct][4 * g4 + 1] + sb) * siluf_(bf_hi(zz.x));
                const float y2 = bf_lo(uu.y) * (acc[ct][4 * g4 + 2] + sb) * siluf_(bf_lo(zz.y)), y3 = bf_hi(uu.y) * (acc[ct][4 * g4 + 3] + sb) * siluf_(bf_hi(zz.y));
                u32x2 w; w.x = cvt_pk_bf16(y0, y1); w.y = cvt_pk_bf16(y2, y3);
                *(u32x2*)(grow + c0) = w;
            }
    }
    __syncthreads();
}

constexpr int XA_STRIDE = 528;
__device__ __forceinline__ void pool_unit(LAS unsigned char* sm, int b, int n, const bf16_t* H1, bf16_t* G, const LayerW& L, float* outP) {
    const int tid = opaque_tid(), lane = tid & 63, wave = __builtin_amdgcn_readfirstlane(tid >> 6), r32 = lane & 31, hi = lane >> 5;
    const int m0 = b * SEQ + n * 128;
    for (int c = tid; c < 143 * 32; c += NTHR) {
        const int i = c >> 5, ch = c & 31;
        u32x4 v = (u32x4){0u, 0u, 0u, 0u};
        if (!(n == 0 && i < 15)) v = *(const u32x4*)(H1 + (size_t)(m0 - 15 + i) * H1W + C_XA + ch * 8);
        *(LAS u32x4*)(sm + i * XA_STRIDE + ch * 16) = v;
        if (outP != nullptr && n == 15 && i >= 128) {
            const size_t o = ((size_t)b * 15 + (i - 128)) * 256 + ch * 8;
            *(f32x4*)(outP + o) = (f32x4){bf_lo(v.x), bf_hi(v.x), bf_lo(v.y), bf_hi(v.y)}; *(f32x4*)(outP + o + 4) = (f32x4){bf_lo(v.z), bf_hi(v.z), bf_lo(v.w), bf_hi(v.w)};
        }
    }
    __syncthreads();
    const int g = wave >> 1, th = wave & 1, wg = 2 << g;
#pragma unroll 1
    for (int ti = 0; ti < 2; ++ti) {
        const int tt = 2 * th + ti, t = 32 * tt + r32, pos = 128 * n + t;
        const float invc = 1.0f / (float)((pos + 1 < wg) ? (pos + 1) : wg);
        f32x16 acc[2]; acc[0] = f32x16{}; acc[1] = f32x16{};
#pragma unroll 1
        for (int ks = 0; ks < 4; ++ks) {
            const int c0 = g * 64 + 16 * ks + 8 * hi;
            const LAS unsigned char* xp = sm + (t + 15) * XA_STRIDE + c0 * 2;
            const u32x4 self = *(const LAS u32x4*)xp;
            float sum[8];
            sum[0] = bf_lo(self.x); sum[1] = bf_hi(self.x); sum[2] = bf_lo(self.y); sum[3] = bf_hi(self.y); sum[4] = bf_lo(self.z); sum[5] = bf_hi(self.z); sum[6] = bf_lo(self.w); sum[7] = bf_hi(self.w);
#pragma unroll 1
            for (int jj = 1; jj < wg; ++jj) {
                const u32x4 v = *(const LAS u32x4*)(xp - jj * XA_STRIDE);
                sum[0] += bf_lo(v.x); sum[1] += bf_hi(v.x); sum[2] += bf_lo(v.y); sum[3] += bf_hi(v.y); sum[4] += bf_lo(v.z); sum[5] += bf_hi(v.z); sum[6] += bf_lo(v.w); sum[7] += bf_hi(v.w);
            }
            u32x4 pw;
            pw.x = cvt_pk_bf16(sum[0] * invc - bf_lo(self.x), sum[1] * invc - bf_hi(self.x)); pw.y = cvt_pk_bf16(sum[2] * invc - bf_lo(self.y), sum[3] * invc - bf_hi(self.y));
            pw.z = cvt_pk_bf16(sum[4] * invc - bf_lo(self.z), sum[5] * invc - bf_hi(self.z)); pw.w = cvt_pk_bf16(sum[6] * invc - bf_lo(self.w), sum[7] * invc - bf_hi(self.w));
            const bf16x8 pf = __builtin_bit_cast(bf16x8, pw);
#pragma unroll
            for (int dt = 0; dt < 2; ++dt) {
                const bf16x8 af = *(const bf16x8*)(L.PWT + ((size_t)(g * 64 + 32 * dt + r32)) * 64 + 16 * ks + 8 * hi);
                acc[dt] = __builtin_amdgcn_mfma_f32_32x32x16_bf16(af, pf, acc[dt], 0, 0, 0);
            }
        }
        const bf16_t* hrow = H1 + (size_t)(m0 + t) * H1W;
        bf16_t* grow = G + (size_t)(m0 + t) * DM + g * 64;
#pragma unroll
        for (int dt = 0; dt < 2; ++dt)
#pragma unroll
            for (int g4 = 0; g4 < 4; ++g4) {
                const int d0 = 32 * dt + 8 * g4 + 4 * hi;
                const f32x4 ps = *(const f32x4*)(L.pool_scale + g * 64 + d0);
                const u32x2 zz = *(const u32x2*)(hrow + C_ZA + g * 64 + d0);
                const float y0 = acc[dt][4 * g4 + 0] * ps[0] * siluf_(bf_lo(zz.x)), y1 = acc[dt][4 * g4 + 1] * ps[1] * siluf_(bf_hi(zz.x));
                const float y2 = acc[dt][4 * g4 + 2] * ps[2] * siluf_(bf_lo(zz.y)), y3 = acc[dt][4 * g4 + 3] * ps[3] * siluf_(bf_hi(zz.y));
                u32x2 w; w.x = cvt_pk_bf16(y0, y1); w.y = cvt_pk_bf16(y2, y3);
                *(u32x2*)(grow + d0) = w;
            }
    }
    __syncthreads();
}

__device__ __forceinline__ void sample_unit(LAS unsigned char* sm, int bs, const bf16_t* H1, bf16_t* G, const LayerW& L, float* outPoolS, float* outKS, float* outVS, float* outCV) {
    const int tid = opaque_tid(), lane = tid & 63, wave = __builtin_amdgcn_readfirstlane(tid >> 6);
    const int m = MP + bs;
    LAS float* hrow = (LAS float*)sm;
    LAS float* pl = hrow + 2560;
    LAS float* sc = pl + 256;
    for (int c = tid; c < H1W; c += NTHR) hrow[c] = bf2f(H1[(size_t)m * H1W + c]);
    __syncthreads();
    bf16_t* grow = G + (size_t)m * DM;
    if (tid < 256) {
        const int g = tid >> 6, wg = 2 << g;
        const float xa = hrow[C_XA + tid];
        float s = xa;
        const float* pb = L.state_pool + (size_t)bs * 15 * 256 + tid;
        for (int j = 0; j < wg - 1; ++j) s += pb[(size_t)(14 - j) * 256];
        pl[tid] = s / (float)wg - xa;
        outPoolS[((size_t)bs * 15 + 14) * 256 + tid] = xa;
    } else {
        const int ch = tid - 256, g = ch >> 6;
        const f32x4 xv = *(const LAS f32x4*)(hrow + C_V + 4 * lane);
        const float mean = wave_sum((xv[0] + xv[1]) + (xv[2] + xv[3])) * (1.f / 256.f);
        const f32x4 dv = xv - mean;
        const float var = wave_sum((dv[0] * dv[0] + dv[1] * dv[1]) + (dv[2] * dv[2] + dv[3] * dv[3])) * (1.f / 256.f);
        const float rstd = 1.0f / sqrtf(var + LN_EPS);
        const float vn = (hrow[C_V + ch] - mean) * rstd * L.sgu_g[ch] + L.sgu_b_ln[ch];
        outCV[(size_t)bs * 256 + ch] = vn;
        const float sv = L.sgu_w[(size_t)g * 128 * 128] * vn + L.sgu_b[g * 128];
        const float yb = hrow[C_U + ch] * sv * siluf_(hrow[C_ZB + ch]);
        grow[256 + ch] = (bf16_t)(cvt_pk_bf16(yb, 0.f) & 0xffffu);
    }
    {
        const int key = tid & 127, hq = tid >> 7, kvh = hq >> 1;
        const float* kp = L.cache_k + (((size_t)bs * 128 + key) * 2 + kvh) * 64;
        const LAS float* q0 = hrow + C_Q + (2 * hq) * 64; const LAS float* q1 = q0 + 64;
        float s0 = 0.f, s1 = 0.f;
#pragma unroll 4
        for (int d = 0; d < 64; d += 4) { const f32x4 kv = *(const f32x4*)(kp + d);
            s0 += kv[0] * q0[d] + kv[1] * q0[d + 1] + kv[2] * q0[d + 2] + kv[3] * q0[d + 3];
            s1 += kv[0] * q1[d] + kv[1] * q1[d + 1] + kv[2] * q1[d + 2] + kv[3] * q1[d + 3]; }
        sc[(2 * hq) * 132 + key] = s0 * 0.125f; sc[(2 * hq + 1) * 132 + key] = s1 * 0.125f;
        if (tid < 8) { const LAS float* q = hrow + C_Q + tid * 64; const LAS float* kn = hrow + C_K + (tid >> 2) * 64; float s = 0.f;
            for (int d = 0; d < 64; ++d) s += q[d] * kn[d];
            sc[tid * 132 + 128] = s * 0.125f; }
        if (tid < 128) { outKS[((size_t)bs * 128 + 127) * 128 + tid] = hrow[C_K + tid]; outVS[((size_t)bs * 128 + 127) * 128 + tid] = hrow[C_VV + tid]; }
    }
    __syncthreads();
    if (tid < 256) {
        const int g = tid >> 6, d = tid & 63;
        const float* pw = L.pool_w + (size_t)g * 64 * 64 + d;
        float s = 0.f;
#pragma unroll 8
        for (int c = 0; c < 64; ++c) s += pl[g * 64 + c] * pw[(size_t)c * 64];
        const float ya = s * L.pool_scale[tid] * siluf_(hrow[C_ZA + tid]);
        grow[tid] = (bf16_t)(cvt_pk_bf16(ya, 0.f) & 0xffffu);
    }
    {
        const int hd = wave;
        const float a0 = sc[hd * 132 + lane], a1 = sc[hd * 132 + 64 + lane], a2 = (lane == 0) ? sc[hd * 132 + 128] : -INFINITY;
        const float sink = L.sinks[hd];
        const float mx = fmaxf(wave_max(fmaxf(fmaxf(a0, a1), a2)), sink);
        const float p0 = __expf(a0 - mx), p1 = __expf(a1 - mx), p2 = (lane == 0) ? __expf(a2 - mx) : 0.f;
        const float den = wave_sum(p0 + p1 + p2) + __expf(sink - mx);
        const float inv = 1.0f / den;
        sc[hd * 132 + lane] = p0 * inv; sc[hd * 132 + 64 + lane] = p1 * inv; if (lane == 0) sc[hd * 132 + 128] = p2 * inv;
    }
    __syncthreads();
    {
        const int hd = wave, kvh = hd >> 2, d = lane;
        const float* vp = L.cache_v + ((size_t)bs * 128 * 2 + kvh) * 64 + d;
        float o = 0.f;
#pragma unroll 8
        for (int key = 0; key < 128; ++key) o += sc[hd * 132 + key] * vp[(size_t)key * 128];
        o += sc[hd * 132 + 128] * hrow[C_VV + kvh * 64 + d];
        const float yc = o * siluf_(hrow[C_ZC + hd * 64 + d]);
        grow[512 + hd * 64 + d] = (bf16_t)(cvt_pk_bf16(yc, 0.f) & 0xffffu);
    }
    __syncthreads();
}


template <int MODE>
__device__ __forceinline__ void sample_gemm(LAS unsigned char* sm, int unit, const bf16_t* A, const bf16_t* Bt, const bf16_t* GT, bf16_t* MGo, float* T, const float* xs, const bf16_t* X1, int layer) {
    const int tid = opaque_tid(), lane = tid & 63, wave = __builtin_amdgcn_readfirstlane(tid >> 6), fr = lane & 15, fq = lane >> 4;
    const int rg = unit >> 6, cg = unit & 63, row0 = MP + rg * 32, col0 = cg * 16;
    const bf16_t* ap = A + (size_t)(row0 + fr) * DM + wave * 128 + fq * 8;
    const bf16_t* bp = Bt + (size_t)(col0 + fr) * DM + wave * 128 + fq * 8;
    bf16x8 af[2][4], bf[4];
#pragma unroll
    for (int ks = 0; ks < 4; ++ks) { bf[ks] = *(const bf16x8*)(bp + ks * 32);
#pragma unroll
        for (int m = 0; m < 2; ++m) af[m][ks] = *(const bf16x8*)(ap + (size_t)m * 16 * DM + ks * 32); }
    f32x4 acc[2]; acc[0] = (f32x4){0.f, 0.f, 0.f, 0.f}; acc[1] = (f32x4){0.f, 0.f, 0.f, 0.f};
#pragma unroll
    for (int ks = 0; ks < 4; ++ks)
#pragma unroll
        for (int m = 0; m < 2; ++m) acc[m] = __builtin_amdgcn_mfma_f32_16x16x32_bf16(bf[ks], af[m][ks], acc[m], 0, 0, 0);
    LAS float* red = (LAS float*)sm;
#pragma unroll
    for (int m = 0; m < 2; ++m) {
        f32x4 v = acc[m];
        if (MODE == 0) { const int seg = wave < 2 ? 0 : (wave < 4 ? 1 : 2);
            const u32x2 g = *(const u32x2*)(GT + (size_t)(row0 + 16 * m + fr) * GW + seg * DM + col0 + 4 * fq);
            v[0] *= bf_lo(g.x); v[1] *= bf_hi(g.x); v[2] *= bf_lo(g.y); v[3] *= bf_hi(g.y); }
        *(LAS f32x4*)(red + ((wave * 2 + m) * 16 + fr) * 16 + 4 * fq) = v;
    }
    __syncthreads();
    {
        const int r = tid >> 4, c = tid & 15;
        float s = 0.f;
#pragma unroll
        for (int w = 0; w < 8; ++w) s += red[((w * 2 + (r >> 4)) * 16 + (r & 15)) * 16 + c];
        const size_t o = (size_t)(row0 + r) * DM + col0 + c;
        if (MODE == 0) MGo[o] = (bf16_t)(cvt_pk_bf16(s, 0.f) & 0xffffu);
        else { const float x = (layer == 0) ? xs[(size_t)(rg * 32 + r) * DM + col0 + c] : bf2f(X1[o]); T[o] = ALPHA * x + s; }
    }
    __syncthreads();
}

__device__ __forceinline__ void ln_rows(const float* T, const float* lg, const float* lb, bf16_t* X1, float* out, int layer, int bid, int ngw) {
    const int tid = opaque_tid(), lane = tid & 63, gw = bid * NWAVES + __builtin_amdgcn_readfirstlane(tid >> 6);
    f32x4 g4[4], b4[4];
#pragma unroll
    for (int j = 0; j < 4; ++j) { g4[j] = *(const f32x4*)(lg + 4 * lane + 256 * j); b4[j] = *(const f32x4*)(lb + 4 * lane + 256 * j); }
    for (int row = gw; row < MREAL; row += ngw) {
        const float* tr = T + (size_t)row * DM + 4 * lane;
        f32x4 v[4]; float s = 0.f;
#pragma unroll
        for (int j = 0; j < 4; ++j) { v[j] = *(const f32x4*)(tr + 256 * j); s += (v[j][0] + v[j][1]) + (v[j][2] + v[j][3]); }
        const float mean = wave_sum(s) * (1.f / DM); float s2 = 0.f;
#pragma unroll
        for (int j = 0; j < 4; ++j) { v[j] = v[j] - mean; s2 += (v[j][0] * v[j][0] + v[j][1] * v[j][1]) + (v[j][2] * v[j][2] + v[j][3] * v[j][3]); }
        const float rstd = 1.0f / sqrtf(wave_sum(s2) * (1.f / DM) + LN_EPS);
        if (layer == 0) {
            bf16_t* xo = X1 + (size_t)row * DM + 4 * lane;
#pragma unroll
            for (int j = 0; j < 4; ++j) { const f32x4 y = v[j] * rstd * g4[j] + b4[j]; u32x2 w; w.x = cvt_pk_bf16(y[0], y[1]); w.y = cvt_pk_bf16(y[2], y[3]); *(u32x2*)(xo + 256 * j) = w; }
        } else {
            float* yo = (row < MP ? out + O_YP + (size_t)row * DM : out + O_YS + (size_t)(row - MP) * DM) + 4 * lane;
#pragma unroll
            for (int j = 0; j < 4; ++j) *(f32x4*)(yo + 256 * j) = v[j] * rstd * g4[j] + b4[j];
        }
    }
}

typedef const Args __attribute__((address_space(4)))* KArgsP;
__device__ __forceinline__ KArgsP kargs() { KArgsP p = (KArgsP)__builtin_amdgcn_kernarg_segment_ptr(); asm volatile("" : "+s"(p)); return p; }

__global__ void __launch_bounds__(NTHR, 2) mk_fwd(Args args) {
    __shared__ __attribute__((aligned(16))) unsigned char smem[LDS_BYTES];
    LAS unsigned char* lds = (LAS unsigned char*)smem;
    const int G = gridDim.x, bid = blockIdx.x;
    for (int u = threadIdx.x; u < (LDS_BYTES - LDSCTL_OFF) / 4; u += NTHR) ((LAS unsigned*)(lds + LDSCTL_OFF))[u] = 0u;
    __syncthreads();
    XcdBarrier bar = xcd_barrier_post((unsigned*)(args.ws + WS_CTL) + 1024, (volatile LAS unsigned*)(lds + LDSCTL_OFF + 64));
#ifdef USE_CG_SYNC
#define GRID_BAR() cg::this_grid().sync()
#else
#define GRID_BAR() xcd_barrier(bar)
#endif
    const int ngw = G * NWAVES;

#pragma unroll 1
    for (int rep = 0; rep < REP_P0; ++rep) {
        KArgsP ap = kargs();
        unsigned char* ws = ap->ws; float* out = ap->out;
        float* ropec = (float*)(ws + WS_ROPE); float* ropes = ropec + ROPE_N;
        bf16_t* PWT = (bf16_t*)(ws + WS_PWT);
        bf16_t* WIN = (bf16_t*)(ws + WS_WIN); bf16_t* WP = (bf16_t*)(ws + WS_WP); bf16_t* WOUT = (bf16_t*)(ws + WS_WOUT);
        bf16_t* XG = (bf16_t*)out;
        const float* x_prompt = ap->in[0]; const float* x_sample = ap->in[1];
        const int tid = opaque_tid(), lane = tid & 63, wave = __builtin_amdgcn_readfirstlane(tid >> 6), gw = bid * NWAVES + wave;
        LAS float* scr = (LAS float*)(lds + wave * 16384);
        for (int it = gw; it < 2 * 3840; it += ngw) {
            const int l = it / 3840; int r = it % 3840;
            if (r < 2816) { p0_transpose_item<true>(ap->in[5] + (size_t)l * DM * DIN, DIN, WIN + (size_t)l * DIN * DM, DM, 0, scr, r, lane); continue; } r -= 2816;
            if (r < 128) { p0_transpose_item<false>(ap->in[14] + (size_t)l * 256 * DM, DM, WP + (size_t)l * DM * DM, DM, 0, scr, r, lane); continue; } r -= 128;
            if (r < 128) { p0_transpose_item<false>(ap->in[15] + (size_t)l * 256 * DM, DM, WP + (size_t)l * DM * DM, DM, 256, scr, r, lane); continue; } r -= 128;
            if (r < 256) { p0_transpose_item<false>(ap->in[16] + (size_t)l * 512 * DM, DM, WP + (size_t)l * DM * DM, DM, 512, scr, r, lane); continue; } r -= 256;
            p0_transpose_item<false>(ap->in[17] + (size_t)l * DM * DM, DM, WOUT + (size_t)l * DM * DM, DM, 0, scr, r, lane);
        }
        for (int row = gw; row < MPAD; row += ngw) {
            bf16_t* xo = XG + (size_t)row * DM + 4 * lane;
            if (row < MREAL) {
                const float* xr = (row < MP ? x_prompt + (size_t)row * DM : x_sample + (size_t)(row - MP) * DM) + 4 * lane;
#pragma unroll
                for (int j = 0; j < 4; ++j) { const f32x4 v = *(const f32x4*)(xr + 256 * j); u32x2 w; w.x = cvt_pk_bf16(v[0], v[1]); w.y = cvt_pk_bf16(v[2], v[3]); *(u32x2*)(xo + 256 * j) = w; }
            } else {
#pragma unroll
                for (int j = 0; j < 4; ++j) *(u32x2*)(xo + 256 * j) = (u32x2){0u, 0u};
            }
        }
        const int gt = bid * NTHR + tid, ngt = G * NTHR;
        for (int e = gt; e < ROPE_N; e += ngt) { const int pi = e >> 5, i = e & 31; const float pos = (pi < 2048) ? (float)pi : 8192.0f; const float ang = pos * ap->inv[i];
            float s, c; sincos_acc(ang, s, c); ropec[e] = c; ropes[e] = s; }
        for (int e = gt; e < 2 * 4 * 64 * 64; e += ngt) { const int c = e & 63, d = (e >> 6) & 63, lg = e >> 12;
            PWT[e] = (bf16_t)(cvt_pk_bf16(ap->in[7][((size_t)lg * 64 + c) * 64 + d], 0.f) & 0xffffu); }
        for (int e = gt; e < 2 * 128 * 127 * 32; e += ngt) { const int q = e % (127 * 32), lb = e / (127 * 32);
            const size_t so = ((size_t)lb * 128 + 1) * 128 + (size_t)q * 4, dof = (size_t)lb * 128 * 128 + (size_t)q * 4;
            *(f32x4*)(out + O_KS + dof) = *(const f32x4*)(ap->in[3] + so); *(f32x4*)(out + O_VS + dof) = *(const f32x4*)(ap->in[4] + so); }
        for (int e = gt; e < 2 * 128 * 14 * 64; e += ngt) { const int q = e % (14 * 64), lb = e / (14 * 64);
            *(f32x4*)(out + O_POOLS + (size_t)lb * 15 * 256 + (size_t)q * 4) = *(const f32x4*)(ap->in[2] + ((size_t)lb * 15 + 1) * 256 + (size_t)q * 4); }
    }
    GRID_BAR();

    {
#ifndef NO_P1
#pragma unroll 1
        for (int rep = 0; rep < REP_P1; ++rep) {
            KArgsP ap = kargs(); unsigned char* ws = ap->ws;
            const bf16_t* Xin = (0 == 0) ? (const bf16_t*)ap->out : (const bf16_t*)(ws + WS_X1);
            pg8::Gemm g{Xin, (const bf16_t*)(ws + WS_WIN) + (size_t)0 * DIN * DM, MPAD, DIN, DM}; pg8::StaticOrder S; S.init(MPAD, DIN, G, bid);
            pg8::EpiInProj E{(bf16_t*)(ws + WS_H1), (bf16_t*)(ws + WS_GT), ap->in[6] + (size_t)0 * 3 * DM, (const float*)(ws + WS_ROPE), (const float*)(ws + WS_ROPE) + ROPE_N};
            pg8::gemm_phase<pg8::EpiInProj, pg8::StaticOrder, true, true>(lds, g, S, E);
        }
#endif
        GRID_BAR();
#pragma unroll 1
        for (int rep = 0; rep < REP_P2; ++rep) {
            KArgsP ap = kargs(); unsigned char* ws = ap->ws; float* out = ap->out;
            const bf16_t* H1 = (const bf16_t*)(ws + WS_H1); bf16_t* XG = (bf16_t*)out;
            LayerW L;
            L.bgate = nullptr; L.pool_w = ap->in[7] + (size_t)0 * 4 * 64 * 64; L.pool_scale = ap->in[8] + (size_t)0 * 256;
            L.sgu_g = ap->in[9] + (size_t)0 * 256; L.sgu_b_ln = ap->in[10] + (size_t)0 * 256; L.sgu_w = ap->in[11] + (size_t)0 * 4 * 128 * 128; L.sgu_b = ap->in[12] + (size_t)0 * 4 * 128;
            L.sinks = ap->in[13] + (size_t)0 * 8; L.ln_g = nullptr; L.ln_b = nullptr;
            L.state_pool = ap->in[2] + (size_t)0 * 128 * 15 * 256; L.cache_k = ap->in[3] + (size_t)0 * 128 * 128 * 128; L.cache_v = ap->in[4] + (size_t)0 * 128 * 128 * 128;
            L.Win_t = nullptr; L.Wp_t = nullptr; L.Wout_t = nullptr; L.PWT = (const bf16_t*)(ws + WS_PWT) + (size_t)0 * 4 * 64 * 64;
            for (int ui = bid; ui < 640; ui += G) {
#ifndef NO_ATT
                if (ui < 256) { const int kvh = ui & 1, bn = ui >> 1; att_unit(lds, bn >> 4, bn & 15, kvh, H1, XG, L.sinks, out + O_KP + (size_t)0 * 8 * 128 * 128, out + O_VP + (size_t)0 * 8 * 128 * 128); }
                else
#endif
#ifndef NO_SGU
                if (ui < 384) { if (ui >= 256) { const int bn = ui - 256; sgu_unit(lds, bn >> 4, bn & 15, H1, XG, L); } }
                else
#endif
#ifndef NO_POOL
                if (ui < 512) { if (ui >= 384) { const int bn = ui - 384; pool_unit(lds, bn >> 4, bn & 15, H1, XG, L, out + O_POOLP + (size_t)0 * 8 * 15 * 256); } }
                else
#endif
#ifndef NO_SAMPLE
                if (ui >= 512) { const int bs = ui - 512; sample_unit(lds, bs, H1, XG, L, out + O_POOLS + (size_t)0 * 128 * 15 * 256, out + O_KS + (size_t)0 * 128 * 128 * 128, out + O_VS + (size_t)0 * 128 * 128 * 128, out + O_CVS + (size_t)0 * 128 * 256); }
#endif
                {}
            }
        }
        GRID_BAR();
#ifndef NO_P3
#pragma unroll 1
        for (int rep = 0; rep < REP_P3; ++rep) {
            KArgsP ap = kargs(); unsigned char* ws = ap->ws;
            pg8::Gemm g{(const bf16_t*)ap->out, (const bf16_t*)(ws + WS_WP) + (size_t)0 * DM * DM, MP, DM, DM}; pg8::StaticOrder S; S.init(MP, DM, G, bid);
            pg8::EpiMerge E{(bf16_t*)(ws + WS_H1), (const bf16_t*)(ws + WS_GT)};
            pg8::gemm_phase<pg8::EpiMerge, pg8::StaticOrder, true, true>(lds, g, S, E);
            for (int su = bid; su < 256; su += G) sample_gemm<0>(lds, su, (const bf16_t*)ap->out, (const bf16_t*)(ws + WS_WP) + (size_t)0 * DM * DM, (const bf16_t*)(ws + WS_GT), (bf16_t*)(ws + WS_H1), nullptr, nullptr, nullptr, 0);
        }
#endif
        GRID_BAR();
#ifndef NO_P4
#pragma unroll 1
        for (int rep = 0; rep < REP_P4; ++rep) {
            KArgsP ap = kargs(); unsigned char* ws = ap->ws;
            pg8::Gemm g{(const bf16_t*)(ws + WS_H1), (const bf16_t*)(ws + WS_WOUT) + (size_t)0 * DM * DM, MP, DM, DM}; pg8::StaticOrder S; S.init(MP, DM, G, bid);
            pg8::EpiOut E{(float*)(ws + WS_GT), ap->in[0], ap->in[1], (const bf16_t*)(ws + WS_X1), 0};
            pg8::gemm_phase<pg8::EpiOut, pg8::StaticOrder, true, true>(lds, g, S, E);
            for (int su = bid; su < 256; su += G) sample_gemm<1>(lds, su, (const bf16_t*)(ws + WS_H1), (const bf16_t*)(ws + WS_WOUT) + (size_t)0 * DM * DM, nullptr, nullptr, (float*)(ws + WS_GT), ap->in[1], (const bf16_t*)(ws + WS_X1), 0);
        }
#endif
        GRID_BAR();
#pragma unroll 1
        for (int rep = 0; rep < REP_P5; ++rep) {
            KArgsP ap = kargs(); unsigned char* ws = ap->ws;
            ln_rows((const float*)(ws + WS_GT), ap->in[18] + (size_t)0 * DM, ap->in[19] + (size_t)0 * DM, (bf16_t*)(ws + WS_X1), ap->out, 0, bid, ngw);
        }
        if (0 + 1 < DEPTH) GRID_BAR();
    }
    {
#ifndef NO_P1
#pragma unroll 1
        for (int rep = 0; rep < REP_P1; ++rep) {
            KArgsP ap = kargs(); unsigned char* ws = ap->ws;
            const bf16_t* Xin = (1 == 0) ? (const bf16_t*)ap->out : (const bf16_t*)(ws + WS_X1);
            pg8::Gemm g{Xin, (const bf16_t*)(ws + WS_WIN) + (size_t)1 * DIN * DM, MPAD, DIN, DM}; pg8::StaticOrder S; S.init(MPAD, DIN, G, bid);
            pg8::EpiInProj E{(bf16_t*)(ws + WS_H1), (bf16_t*)(ws + WS_GT), ap->in[6] + (size_t)1 * 3 * DM, (const float*)(ws + WS_ROPE), (const float*)(ws + WS_ROPE) + ROPE_N};
            pg8::gemm_phase<pg8::EpiInProj, pg8::StaticOrder, true, true>(lds, g, S, E);
        }
#endif
        GRID_BAR();
#pragma unroll 1
        for (int rep = 0; rep < REP_P2; ++rep) {
            KArgsP ap = kargs(); unsigned char* ws = ap->ws; float* out = ap->out;
            const bf16_t* H1 = (const bf16_t*)(ws + WS_H1); bf16_t* XG = (bf16_t*)out;
            LayerW L;
            L.bgate = nullptr; L.pool_w = ap->in[7] + (size_t)1 * 4 * 64 * 64; L.pool_scale = ap->in[8] + (size_t)1 * 256;
            L.sgu_g = ap->in[9] + (size_t)1 * 256; L.sgu_b_ln = ap->in[10] + (size_t)1 * 256; L.sgu_w = ap->in[11] + (size_t)1 * 4 * 128 * 128; L.sgu_b = ap->in[12] + (size_t)1 * 4 * 128;
            L.sinks = ap->in[13] + (size_t)1 * 8; L.ln_g = nullptr; L.ln_b = nullptr;
            L.state_pool = ap->in[2] + (size_t)1 * 128 * 15 * 256; L.cache_k = ap->in[3] + (size_t)1 * 128 * 128 * 128; L.cache_v = ap->in[4] + (size_t)1 * 128 * 128 * 128;
            L.Win_t = nullptr; L.Wp_t = nullptr; L.Wout_t = nullptr; L.PWT = (const bf16_t*)(ws + WS_PWT) + (size_t)1 * 4 * 64 * 64;
            for (int ui = bid; ui < 640; ui += G) {
#ifndef NO_ATT
                if (ui < 256) { const int kvh = ui & 1, bn = ui >> 1; att_unit(lds, bn >> 4, bn & 15, kvh, H1, XG, L.sinks, out + O_KP + (size_t)1 * 8 * 128 * 128, out + O_VP + (size_t)1 * 8 * 128 * 128); }
                else
#endif
#ifndef NO_SGU
                if (ui < 384) { if (ui >= 256) { const int bn = ui - 256; sgu_unit(lds, bn >> 4, bn & 15, H1, XG, L); } }
                else
#endif
#ifndef NO_POOL
                if (ui < 512) { if (ui >= 384) { const int bn = ui - 384; pool_unit(lds, bn >> 4, bn & 15, H1, XG, L, out + O_POOLP + (size_t)1 * 8 * 15 * 256); } }
                else
#endif
#ifndef NO_SAMPLE
                if (ui >= 512) { const int bs = ui - 512; sample_unit(lds, bs, H1, XG, L, out + O_POOLS + (size_t)1 * 128 * 15 * 256, out + O_KS + (size_t)1 * 128 * 128 * 128, out + O_VS + (size_t)1 * 128 * 128 * 128, out + O_CVS + (size_t)1 * 128 * 256); }
#endif
                {}
            }
        }
        GRID_BAR();
#ifndef NO_P3
#pragma unroll 1
        for (int rep = 0; rep < REP_P3; ++rep) {
            KArgsP ap = kargs(); unsigned char* ws = ap->ws;
            pg8::Gemm g{(const bf16_t*)ap->out, (const bf16_t*)(ws + WS_WP) + (size_t)1 * DM * DM, MP, DM, DM}; pg8::StaticOrder S; S.init(MP, DM, G, bid);
            pg8::EpiMerge E{(bf16_t*)(ws + WS_H1), (const bf16_t*)(ws + WS_GT)};
            pg8::gemm_phase<pg8::EpiMerge, pg8::StaticOrder, true, true>(lds, g, S, E);
            for (int su = bid; su < 256; su += G) sample_gemm<0>(lds, su, (const bf16_t*)ap->out, (const bf16_t*)(ws + WS_WP) + (size_t)1 * DM * DM, (const bf16_t*)(ws + WS_GT), (bf16_t*)(ws + WS_H1), nullptr, nullptr, nullptr, 1);
        }
#endif
        GRID_BAR();
#ifndef NO_P4
#pragma unroll 1
        for (int rep = 0; rep < REP_P4; ++rep) {
            KArgsP ap = kargs(); unsigned char* ws = ap->ws;
            pg8::Gemm g{(const bf16_t*)(ws + WS_H1), (const bf16_t*)(ws + WS_WOUT) + (size_t)1 * DM * DM, MP, DM, DM}; pg8::StaticOrder S; S.init(MP, DM, G, bid);
            pg8::EpiOut E{(float*)(ws + WS_GT), ap->in[0], ap->in[1], (const bf16_t*)(ws + WS_X1), 1};
            pg8::gemm_phase<pg8::EpiOut, pg8::StaticOrder, true, true>(lds, g, S, E);
            for (int su = bid; su < 256; su += G) sample_gemm<1>(lds, su, (const bf16_t*)(ws + WS_H1), (const bf16_t*)(ws + WS_WOUT) + (size_t)1 * DM * DM, nullptr, nullptr, (float*)(ws + WS_GT), ap->in[1], (const bf16_t*)(ws + WS_X1), 1);
        }
#endif
        GRID_BAR();
#pragma unroll 1
        for (int rep = 0; rep < REP_P5; ++rep) {
            KArgsP ap = kargs(); unsigned char* ws = ap->ws;
            ln_rows((const float*)(ws + WS_GT), ap->in[18] + (size_t)1 * DM, ap->in[19] + (size_t)1 * DM, (bf16_t*)(ws + WS_X1), ap->out, 1, bid, ngw);
        }
        if (1 + 1 < DEPTH) GRID_BAR();
    }
#undef GRID_BAR
    if (kargs()->use_cg != 0) { cg::this_grid().sync(); }
}

extern "C" void kernel_launch(void* const* d_in, const int* in_sizes, int n_in, void* d_out, int out_size, void* d_ws, size_t ws_size, hipStream_t stream) {
    static int grid = 0;
    if (grid == 0) {
        if (n_in != 20 || ws_size < WS_END) { fprintf(stderr, "kernel_launch: unexpected n_in %d / ws %zu\n", n_in, ws_size); grid = -1; return; }
        int dev = 0, cus = 0, per_cu = 0;
        if (hipGetDevice(&dev) != hipSuccess || hipDeviceGetAttribute(&cus, hipDeviceAttributeMultiprocessorCount, dev) != hipSuccess) { grid = -1; return; }
        if (hipOccupancyMaxActiveBlocksPerMultiprocessor(&per_cu, (const void*)mk_fwd, NTHR, 0) != hipSuccess || per_cu < 1) { fprintf(stderr, "kernel_launch: occupancy query says %d\n", per_cu); (void)hipGetLastError(); grid = -1; return; }
        grid = cus;
        if (grid > cus * per_cu) grid = cus * per_cu;
    }
    if (grid < 0) return;
    (void)hipMemsetAsync((char*)d_ws + WS_CTL, 0, CTL_ZERO_BYTES, stream);
    Args a{};
    for (int i = 0; i < 20; ++i) a.in[i] = (const float*)d_in[i];
    a.out = (float*)d_out; a.ws = (unsigned char*)d_ws;
    for (int i = 0; i < 32; ++i) a.inv[i] = (float)pow(10000.0, -(double)i / 32.0);
    a.use_cg = 0; a.pad = 0;
    void* kargs[] = {&a};
    hipError_t e = hipLaunchCooperativeKernel((const void*)mk_fwd, dim3(grid), dim3(NTHR), kargs, 0, stream);
    if (e != hipSuccess) fprintf(stderr, "cooperative launch failed: %s (grid %d)\n", hipGetErrorString(e), grid);
}
```
